# Optimizing an MI355X kernel written in HIP

```python
import math
import jax, jax.numpy as jnp
from jax import lax
import numpy as np

D_MODEL = 1024
BATCH = 2
SEQ = 8192
DEPTH = 2

N_META = 16
N_A = DEPTH // 2
N_B = DEPTH - N_A
N_HEADS = 8
HEAD_DIM = D_MODEL // N_HEADS
D_FF = 2816
CONV_WIDTH = 3
BLOCK = 128
PAD = (-N_META) % BLOCK
LN_EPS = 1e-5
DEEPNORM_ALPHA = (2 * DEPTH) ** 0.25
DEEPNORM_BETA = (8 * DEPTH) ** -0.25
NEG_INF = -1e30

kernel_name = "yoco_shortconv_fox_macaron_deepnorm"


def layer_norm(x, g, b):
    xf = x.astype(jnp.float32)
    mu = jnp.mean(xf, axis=-1, keepdims=True)
    var = jnp.mean(jnp.square(xf - mu), axis=-1, keepdims=True)
    y = (xf - mu) * lax.rsqrt(var + LN_EPS) * g.astype(jnp.float32) + b.astype(jnp.float32)
    return y.astype(x.dtype)


def swiglu(x, wg, wu, wd):
    return (jax.nn.silu(x @ wg) * (x @ wu)) @ wd


def short_conv(x, w_in, w_conv, w_out):
    bgate, cgate, val = jnp.split(x @ w_in, 3, axis=-1)
    u = cgate * val
    y = lax.conv_general_dilated(
        u, w_conv[:, None, :].astype(u.dtype),
        window_strides=(1,), padding=[(CONV_WIDTH - 1, 0)],
        dimension_numbers=("NWC", "WIO", "NWC"),
        feature_group_count=D_MODEL)
    return (bgate * y) @ w_out


def shared_kv(h, kv_w, f_bias):
    bsz, L, _ = h.shape
    kvf = h @ kv_w
    k = kvf[..., :D_MODEL].reshape(bsz, L, N_HEADS, HEAD_DIM)
    v = kvf[..., D_MODEL:2 * D_MODEL].reshape(bsz, L, N_HEADS, HEAD_DIM)
    f_logit = (kvf[..., 2 * D_MODEL:] + f_bias).astype(jnp.float32)
    log_f = jax.nn.log_sigmoid(f_logit)
    pad4 = ((0, 0), (PAD, 0), (0, 0), (0, 0))
    k = jnp.pad(k, pad4).transpose(0, 2, 1, 3)
    v = jnp.pad(v, pad4).transpose(0, 2, 1, 3)
    log_f = jnp.pad(log_f, ((0, 0), (PAD, 0), (0, 0)))
    c = jnp.cumsum(log_f, axis=1).transpose(0, 2, 1)
    return k, v, c


def forgetting_attention(h, w_q, w_o, k, v, c):
    bsz, L, _ = h.shape
    Lp = L + PAD
    n_blocks = Lp // BLOCK
    scale = 1.0 / math.sqrt(HEAD_DIM)
    q = (h @ w_q).reshape(bsz, L, N_HEADS, HEAD_DIM)
    q = jnp.pad(q, ((0, 0), (PAD, 0), (0, 0), (0, 0))).transpose(0, 2, 1, 3)
    k_pos = jnp.arange(Lp)

    def one_block(i):
        start = i * BLOCK
        qb = lax.dynamic_slice_in_dim(q, start, BLOCK, axis=2)
        cq = lax.dynamic_slice_in_dim(c, start, BLOCK, axis=2)
        s = jnp.einsum("bhqd,bhkd->bhqk", qb, k).astype(jnp.float32) * scale
        s = s + cq[..., :, None] - c[..., None, :]
        q_pos = start + jnp.arange(BLOCK)
        mask = (k_pos[None, :] <= q_pos[:, None]) & (k_pos[None, :] >= PAD)
        s = jnp.where(mask, s, NEG_INF)
        p = jax.nn.softmax(s, axis=-1)
        return jnp.einsum("bhqk,bhkd->bhqd", p.astype(v.dtype), v)

    o = lax.map(one_block, jnp.arange(n_blocks))
    o = o.transpose(1, 0, 3, 2, 4).reshape(bsz, Lp, D_MODEL)[:, PAD:]
    return o @ w_o


def setup_inputs(seed: int = 0) -> dict:
    key = jax.random.key(seed)
    ks = jax.random.split(key, 20)
    f32 = jnp.float32

    def nrm(k, shape, scale):
        return jax.random.normal(k, shape, f32) * scale

    d_s = D_MODEL ** -0.5
    f_s = D_FF ** -0.5
    x = nrm(ks[0], (BATCH, SEQ, D_MODEL), 1.0)
    meta = nrm(ks[1], (N_META, D_MODEL), 1.0)
    ffn1_wg = nrm(ks[2], (DEPTH, D_MODEL, D_FF), d_s)
    ffn1_wu = nrm(ks[3], (DEPTH, D_MODEL, D_FF), d_s)
    ffn1_wd = nrm(ks[4], (DEPTH, D_FF, D_MODEL), f_s * DEEPNORM_BETA)
    ffn2_wg = nrm(ks[5], (DEPTH, D_MODEL, D_FF), d_s)
    ffn2_wu = nrm(ks[6], (DEPTH, D_MODEL, D_FF), d_s)
    ffn2_wd = nrm(ks[7], (DEPTH, D_FF, D_MODEL), f_s * DEEPNORM_BETA)
    ln_gain = 1.0 + nrm(ks[8], (DEPTH, 3, D_MODEL), 0.02)
    ln_bias = nrm(ks[9], (DEPTH, 3, D_MODEL), 0.02)
    conv_w_in = nrm(ks[10], (N_A, D_MODEL, 3 * D_MODEL), d_s)
    conv_w = nrm(ks[11], (N_A, CONV_WIDTH, D_MODEL), CONV_WIDTH ** -0.5)
    conv_w_out = nrm(ks[12], (N_A, D_MODEL, D_MODEL), d_s * DEEPNORM_BETA)
    w_k = nrm(ks[13], (D_MODEL, D_MODEL), d_s)
    w_v = nrm(ks[14], (D_MODEL, D_MODEL), d_s * DEEPNORM_BETA)
    w_f = nrm(ks[15], (D_MODEL, N_HEADS), d_s * 0.5)
    kv_w = jnp.concatenate([w_k, w_v, w_f], axis=1)
    f_bias = 3.0 + nrm(ks[16], (N_HEADS,), 0.5)
    attn_w_q = nrm(ks[17], (N_B, D_MODEL, D_MODEL), d_s)
    attn_w_o = nrm(ks[18], (N_B, D_MODEL, D_MODEL), d_s * DEEPNORM_BETA)
    return {"x": x, "meta": meta,
            "ffn1_wg": ffn1_wg, "ffn1_wu": ffn1_wu, "ffn1_wd": ffn1_wd,
            "ffn2_wg": ffn2_wg, "ffn2_wu": ffn2_wu, "ffn2_wd": ffn2_wd,
            "ln_gain": ln_gain, "ln_bias": ln_bias,
            "conv_w_in": conv_w_in, "conv_w": conv_w, "conv_w_out": conv_w_out,
            "kv_w": kv_w, "f_bias": f_bias,
            "attn_w_q": attn_w_q, "attn_w_o": attn_w_o}


def reference(x, meta, ffn1_wg, ffn1_wu, ffn1_wd, ffn2_wg, ffn2_wu, ffn2_wd,
              ln_gain, ln_bias, conv_w_in, conv_w, conv_w_out, kv_w, f_bias,
              attn_w_q, attn_w_o):
    bsz = x.shape[0]
    h = jnp.concatenate(
        [jnp.broadcast_to(meta.astype(x.dtype)[None], (bsz, N_META, D_MODEL)), x], axis=1)
    k_sh = v_sh = c_sh = None
    for l in range(DEPTH):
        h = layer_norm(DEEPNORM_ALPHA * h + 0.5 * swiglu(h, ffn1_wg[l], ffn1_wu[l], ffn1_wd[l]),
                       ln_gain[l, 0], ln_bias[l, 0])
        if l < N_A:
            mix = short_conv(h, conv_w_in[l], conv_w[l], conv_w_out[l])
        else:
            j = l - N_A
            mix = forgetting_attention(h, attn_w_q[j], attn_w_o[j], k_sh, v_sh, c_sh)
        h = layer_norm(DEEPNORM_ALPHA * h + mix, ln_gain[l, 1], ln_bias[l, 1])
        h = layer_norm(DEEPNORM_ALPHA * h + 0.5 * swiglu(h, ffn2_wg[l], ffn2_wu[l], ffn2_wd[l]),
                       ln_gain[l, 2], ln_bias[l, 2])
        if l == N_A - 1:
            k_sh, v_sh, c_sh = shared_kv(h, kv_w, f_bias)
    return h[:, N_META:]
```

```cpp
#include <hip/hip_runtime.h>
#include <hip/hip_bf16.h>
#include <hip/hip_cooperative_groups.h>
#include <cstdio>
#include <cstdint>
namespace cg = cooperative_groups;

namespace pg8 {
#define PG8_LAS __attribute__((address_space(3)))
typedef unsigned short bf16_t;
typedef short bf16x8 __attribute__((ext_vector_type(8)));
typedef float f32x4 __attribute__((ext_vector_type(4)));
typedef unsigned u32x4 __attribute__((ext_vector_type(4)));
constexpr int BM = 256, BK = 64, HALF = 128, HTB = HALF * BK * 2  , STAGE_BYTES = 8 * HTB, NXCD = 8, WGM = 8;

__host__ __device__ __forceinline__ int lds_byte(int r, int c) { const int st = (r >> 4) * 2 + (c >> 5), rr = r & 15, cc = c & 31, ob = rr * 64 + cc * 2; return st * 1024 + (ob ^ (((ob >> 9) & 1) << 5)); }
__host__ __device__ __forceinline__ void stage_rc(int b, int& R, int& C) { const int st = b / 1024, sb = b % 1024, swz = sb ^ (((sb >> 9) & 1) << 5); R = (st >> 1) * 16 + swz / 64; C = (st & 1) * 32 + (swz % 64) / 2; }
__host__ __device__ __forceinline__ int perm32(int rho) { const int n = rho >> 4, i = rho & 15; return 8 * (i >> 2) + 4 * n + (i & 3); }

struct Unit { int pm, pn; };
struct Gemm { const bf16_t* A; const bf16_t* Bt; int M, N, K; };

struct StaticOrder {
    int nM, nN, nwg, G, c;
    __host__ __device__ void init(int M, int N, int G_, int c_) { nM = M / BM; nN = N / BM; nwg = nM * nN; G = G_; c = c_; }
    __host__ __device__ bool next(int i, Unit& u) const {
        const long L = (long)i * G + c; if (L >= nwg) return false;
        int wgid = (int)L; { const int q = nwg / NXCD, r = nwg % NXCD, xcd = wgid % NXCD, off = wgid / NXCD; wgid = (xcd < r ? xcd * (q + 1) : r * (q + 1) + (xcd - r) * q) + off; }
        const int nig = WGM * nN, gid = wgid / nig, fm = gid * WGM, gsz = (nM - fm) < WGM ? (nM - fm) : WGM;
        u.pm = fm + ((wgid % nig) % gsz); u.pn = (wgid % nig) / gsz; return true;
    }
    __device__ __forceinline__ void a_ready(const Unit&) const {}
    __device__ __forceinline__ void done(const Unit&) const {}
};
__device__ __forceinline__ unsigned cvt_pk_bf16(float lo, float hi) { unsigned r; asm volatile("v_cvt_pk_bf16_f32 %0, %1, %2" : "=v"(r) : "v"(lo), "v"(hi)); return r; }
__device__ __forceinline__ u32x4 pack8(f32x4 a, f32x4 b) { u32x4 w; w.x = cvt_pk_bf16(a[0], a[1]); w.y = cvt_pk_bf16(a[2], a[3]); w.z = cvt_pk_bf16(b[0], b[1]); w.w = cvt_pk_bf16(b[2], b[3]); return w; }
__device__ __forceinline__ float silu_mul(float g, float u) { return g * __builtin_amdgcn_rcpf(1.0f + __builtin_amdgcn_exp2f(-1.4426950408889634f * g)) * u; }
__device__ __forceinline__ f32x4 silu_mul4(f32x4 g, f32x4 u) { return (f32x4){silu_mul(g[0], u[0]), silu_mul(g[1], u[1]), silu_mul(g[2], u[2]), silu_mul(g[3], u[3])}; }
constexpr int TOKROWS = 16384;
struct EpiSwiglu {
    static constexpr bool PERM = true, AFTER_DRAIN = false;
    bf16_t* act; int ldc;
    __device__ __forceinline__ void operator()(const f32x4 (&acc)[2][2][4][2], const Unit& u, int wr, int wc, int fr, int fq) const {
        const int row0 = u.pm * BM + wr * 64 + fr, col = u.pn * 128 + wc * 32 + 8 * fq;
#pragma unroll
        for (int ai = 0; ai < 2; ++ai)
#pragma unroll
            for (int m = 0; m < 4; ++m) { bf16_t* p = act + (size_t)(row0 + ai * HALF + m * 16) * ldc + col;
                *(u32x4*)p = pack8(silu_mul4(acc[ai][0][m][0], acc[ai][1][m][0]), silu_mul4(acc[ai][0][m][1], acc[ai][1][m][1])); }
    }
};
struct EpiResid {
    static constexpr bool PERM = true, AFTER_DRAIN = false;
    const float* src; float* dst; const float* src_m; float* dst_m; float scale;
    __device__ __forceinline__ void operator()(const f32x4 (&acc)[2][2][4][2], const Unit& u, int wr, int wc, int fr, int fq) const {
        const bool meta = u.pm * BM >= TOKROWS;
        const float* s = meta ? src_m : src + (size_t)u.pm * BM * 1024; float* d = meta ? dst_m : dst + (size_t)u.pm * BM * 1024;
        const int r0 = wr * 64 + fr, c0 = u.pn * BM + wc * 32 + 8 * fq; const float ALPHA = 1.4142135623730951f;
#pragma unroll
        for (int ai = 0; ai < 2; ++ai)
#pragma unroll
            for (int m = 0; m < 4; ++m)
#pragma unroll
                for (int bj = 0; bj < 2; ++bj) { const size_t off = (size_t)(r0 + ai * HALF + m * 16) * 1024 + c0 + bj * HALF;
                    const f32x4 a0 = *(const f32x4*)(s + off), a1 = *(const f32x4*)(s + off + 4);
                    *(f32x4*)(d + off) = a0 * ALPHA + acc[ai][bj][m][0] * scale; *(f32x4*)(d + off + 4) = a1 * ALPHA + acc[ai][bj][m][1] * scale; }
    }
};
struct EpiConvIn {
    static constexpr bool PERM = true, AFTER_DRAIN = false;
    bf16_t* ub; bf16_t* bb;
    __device__ __forceinline__ void operator()(const f32x4 (&acc)[2][2][4][2], const Unit& u, int wr, int wc, int fr, int fq) const {
        const int row0 = u.pm * BM + wr * 64 + fr;
        if (u.pn < 8) { const int col = u.pn * 128 + wc * 32 + 8 * fq;
#pragma unroll
            for (int ai = 0; ai < 2; ++ai)
#pragma unroll
                for (int m = 0; m < 4; ++m) *(u32x4*)(ub + (size_t)(row0 + ai * HALF + m * 16) * 1024 + col) = pack8(acc[ai][0][m][0] * acc[ai][1][m][0], acc[ai][0][m][1] * acc[ai][1][m][1]);
        } else { const int col = (u.pn - 8) * BM + wc * 32 + 8 * fq;
#pragma unroll
            for (int ai = 0; ai < 2; ++ai)
#pragma unroll
                for (int m = 0; m < 4; ++m)
#pragma unroll
                    for (int bj = 0; bj < 2; ++bj) *(u32x4*)(bb + (size_t)(row0 + ai * HALF + m * 16) * 1024 + col + bj * HALF) = pack8(acc[ai][bj][m][0], acc[ai][bj][m][1]);
        }
    }
};
constexpr int KVPOS = 8256;
struct EpiKV {
    static constexpr bool PERM = true, AFTER_DRAIN = false;
    bf16_t* Kb; bf16_t* Vb;
    __device__ __forceinline__ void operator()(const f32x4 (&acc)[2][2][4][2], const Unit& u, int wr, int wc, int fr, int fq) const {
        bf16_t* base = (u.pn < 4) ? Kb : Vb; const int h0 = (u.pn & 3) * 2, d = wc * 32 + 8 * fq;
        if (u.pm * BM < TOKROWS) {
#pragma unroll
            for (int ai = 0; ai < 2; ++ai)
#pragma unroll
                for (int m = 0; m < 4; ++m) { const int r = u.pm * BM + ai * HALF + wr * 64 + m * 16 + fr, b = r >> 13, t = r & 8191;
#pragma unroll
                    for (int bj = 0; bj < 2; ++bj) *(u32x4*)(base + ((size_t)(b * 8 + h0 + bj) * KVPOS + 16 + t) * 128 + d) = pack8(acc[ai][bj][m][0], acc[ai][bj][m][1]); }
        } else if (wr == 0) {
#pragma unroll
            for (int bj = 0; bj < 2; ++bj) { const u32x4 w = pack8(acc[0][bj][0][0], acc[0][bj][0][1]);
                *(u32x4*)(base + ((size_t)(0 * 8 + h0 + bj) * KVPOS + fr) * 128 + d) = w; *(u32x4*)(base + ((size_t)(1 * 8 + h0 + bj) * KVPOS + fr) * 128 + d) = w; }
        }
    }
};
struct EpiQ {
    static constexpr bool PERM = true, AFTER_DRAIN = false;
    bf16_t* Q;
    __device__ __forceinline__ void operator()(const f32x4 (&acc)[2][2][4][2], const Unit& u, int wr, int wc, int fr, int fq) const {
        const int h0 = u.pn * 2, d = wc * 32 + 8 * fq;
#pragma unroll
        for (int ai = 0; ai < 2; ++ai)
#pragma unroll
            for (int m = 0; m < 4; ++m) { const int r = u.pm * BM + ai * HALF + wr * 64 + m * 16 + fr, b = r >> 13, t = r & 8191;
#pragma unroll
                for (int bj = 0; bj < 2; ++bj) *(u32x4*)(Q + ((size_t)(b * 8 + h0 + bj) * 8192 + t) * 128 + d) = pack8(acc[ai][bj][m][0], acc[ai][bj][m][1]); }
    }
};

template <class Epi, class Sched, bool ALIGN_EPI = false, bool SP2 = false>
__device__ __forceinline__ void gemm_phase(PG8_LAS unsigned char* lds, const Gemm g, const Sched& S, const Epi& E) {
    int tid_ = threadIdx.x; asm volatile("" : "+v"(tid_));
    const int tid = tid_, wid = __builtin_amdgcn_readfirstlane(tid >> 6), lane = tid & 63, wr = wid >> 2, wc = wid & 3, fr = lane & 15, fq = lane >> 4;
    const int K = g.K, nt = K / BK;
    unsigned voffA[2], voffB[2];
#pragma unroll
    for (int i = 0; i < 2; ++i) { int R, C; stage_rc(tid * 16 + i * 8192, R, C); const int Rb = Epi::PERM ? ((R & ~31) + perm32(R & 31)) : R;
        voffA[i] = (unsigned)(R * K + C) * 2u; voffB[i] = (unsigned)(Rb * K + C) * 2u; }
    const size_t kstep = (size_t)(BK * 2);
    const size_t hstep = (size_t)HALF * K * 2;
    const size_t tstep = 2 * hstep;
    const unsigned ldsw = (unsigned)wid * 1024u;
    const int aoff = lds_byte(wr * 64 + fr, fq * 8), boff = lds_byte(wc * 32 + fr, fq * 8);
#define PG8_SA(b, h) (((b) * 2 + (h)) * HTB)
#define PG8_SB(b, h) ((4 + (b) * 2 + (h)) * HTB)
#define PG8_STAGE(bufoff, gbase, voff) do { _Pragma("unroll") for (int _i = 0; _i < 2; ++_i) \
        __builtin_amdgcn_global_load_lds((const unsigned*)((const char*)(gbase) + (voff)[_i]), (PG8_LAS unsigned*)(lds + (bufoff) + ldsw + _i * 8192), 16, 0, 0); } while (0)
#define PG8_LDA(dst, b, h) do { _Pragma("unroll") for (int m = 0; m < 4; ++m) _Pragma("unroll") for (int k = 0; k < 2; ++k) dst[m][k] = *(const PG8_LAS bf16x8*)(lds + PG8_SA(b, h) + aoff + m * 2048 + k * 1024); } while (0)
#define PG8_LDB(dst, b, h) do { _Pragma("unroll") for (int n = 0; n < 2; ++n) _Pragma("unroll") for (int k = 0; k < 2; ++k) dst[n][k] = *(const PG8_LAS bf16x8*)(lds + PG8_SB(b, h) + boff + n * 2048 + k * 1024); } while (0)
#define PG8_MMA(ai, bj, At, Bt) do { __builtin_amdgcn_s_setprio(1); _Pragma("unroll") for (int m = 0; m < 4; ++m) _Pragma("unroll") for (int n = 0; n < 2; ++n) _Pragma("unroll") for (int k = 0; k < 2; ++k) \
        acc[ai][bj][m][n] = __builtin_amdgcn_mfma_f32_16x16x32_bf16(Bt[n][k], At[m][k], acc[ai][bj][m][n], 0, 0, 0); __builtin_amdgcn_s_setprio(0); } while (0)
#define PG8_WAIT_V(n) asm volatile("s_waitcnt vmcnt(" #n ")" ::: "memory")
#define PG8_WAIT_L(n) asm volatile("s_waitcnt lgkmcnt(" #n ")" ::: "memory")
#define PG8_BAR __builtin_amdgcn_s_barrier()
#define PG8_SCHED __builtin_amdgcn_sched_barrier(0)
    Unit cur, nxt; int ui = 0;
    if (!S.next(0, cur)) return;
    f32x4 acc[2][2][4][2];
#pragma unroll
    for (int a = 0; a < 2; ++a)
#pragma unroll
        for (int b = 0; b < 2; ++b)
#pragma unroll
            for (int m = 0; m < 4; ++m)
#pragma unroll
                for (int n = 0; n < 2; ++n) acc[a][b][m][n] = (f32x4){0.f, 0.f, 0.f, 0.f};
    bf16x8 At[4][2], B0[2][2], B1[2][2];
    const char* cA = (const char*)g.A + (size_t)cur.pm * tstep; const char* cB = (const char*)g.Bt + (size_t)cur.pn * tstep;
    S.a_ready(cur);
    if constexpr (SP2) {
        PG8_STAGE(PG8_SB(0, 0), cB, voffB); PG8_STAGE(PG8_SB(0, 1), cB + hstep, voffB); PG8_STAGE(PG8_SA(0, 0), cA, voffA); PG8_STAGE(PG8_SA(0, 1), cA + hstep, voffA);
        if (wr == 1) PG8_BAR;
        PG8_WAIT_V(2); PG8_BAR;
        PG8_STAGE(PG8_SB(1, 0), cB + kstep, voffB); PG8_STAGE(PG8_SA(1, 0), cA + kstep, voffA); PG8_STAGE(PG8_SB(1, 1), cB + hstep + kstep, voffB);
        PG8_WAIT_V(6); PG8_BAR;
    } else {
        PG8_STAGE(PG8_SB(0, 0), cB, voffB); PG8_STAGE(PG8_SA(0, 0), cA, voffA); PG8_STAGE(PG8_SB(0, 1), cB + hstep, voffB); PG8_STAGE(PG8_SA(0, 1), cA + hstep, voffA);
        if (wr == 1) PG8_BAR;
        PG8_WAIT_V(4); PG8_BAR;
        PG8_STAGE(PG8_SB(1, 0), cB + kstep, voffB); PG8_STAGE(PG8_SA(1, 0), cA + kstep, voffA); PG8_STAGE(PG8_SB(1, 1), cB + hstep + kstep, voffB);
        PG8_WAIT_V(6); PG8_BAR;
    }
    for (;;) {
        const bool has_next = S.next(ui + 1, nxt);
        const char* nA = has_next ? (const char*)g.A + (size_t)nxt.pm * tstep : cA; const char* nB = has_next ? (const char*)g.Bt + (size_t)nxt.pn * tstep : cB;
        for (int t = 0; t < nt; t += 2) {
            const bool last = (t == nt - 2);
            const char* a1 = cA + (size_t)(t + 1) * kstep;
            const char* a2 = last ? nA : cA + (size_t)(t + 2) * kstep; const char* b2 = last ? nB : cB + (size_t)(t + 2) * kstep;
            const char* a3 = a2 + kstep; const char* b3 = b2 + kstep;
            if (last && has_next) S.a_ready(nxt);
            if constexpr (SP2) {
            PG8_LDB(B0, 0, 0); PG8_LDB(B1, 0, 1); PG8_SCHED; PG8_LDA(At, 0, 0); PG8_STAGE(PG8_SA(1, 1), a1 + hstep, voffA);
            PG8_WAIT_V(8); PG8_WAIT_L(0); PG8_BAR; PG8_MMA(0, 0, At, B0); PG8_MMA(0, 1, At, B1); PG8_BAR; PG8_SCHED;
            PG8_LDA(At, 0, 1); PG8_STAGE(PG8_SB(0, 0), b2, voffB); PG8_STAGE(PG8_SB(0, 1), b2 + hstep, voffB); PG8_STAGE(PG8_SA(0, 0), a2, voffA);
            PG8_WAIT_V(8); PG8_WAIT_L(0); PG8_BAR; PG8_MMA(1, 0, At, B0); PG8_MMA(1, 1, At, B1); PG8_BAR; PG8_SCHED;
            PG8_LDB(B0, 1, 0); PG8_LDB(B1, 1, 1); PG8_SCHED; PG8_LDA(At, 1, 0); PG8_STAGE(PG8_SA(0, 1), a2 + hstep, voffA);
            PG8_WAIT_V(8); PG8_WAIT_L(0); PG8_BAR; PG8_MMA(0, 0, At, B0); PG8_MMA(0, 1, At, B1); PG8_BAR; PG8_SCHED;
            PG8_LDA(At, 1, 1); PG8_STAGE(PG8_SB(1, 0), b3, voffB); PG8_STAGE(PG8_SB(1, 1), b3 + hstep, voffB); PG8_STAGE(PG8_SA(1, 0), a3, voffA);
            PG8_WAIT_V(8); PG8_WAIT_L(0); PG8_BAR; PG8_MMA(1, 0, At, B0); PG8_MMA(1, 1, At, B1); PG8_BAR; PG8_SCHED;
            } else {
            PG8_LDB(B0, 0, 0); PG8_SCHED; PG8_LDA(At, 0, 0); PG8_STAGE(PG8_SA(1, 1), a1 + hstep, voffA);
            PG8_WAIT_L(8); PG8_BAR; PG8_WAIT_L(0); PG8_MMA(0, 0, At, B0); PG8_BAR; PG8_SCHED;
            PG8_LDB(B1, 0, 1); PG8_STAGE(PG8_SB(0, 0), b2, voffB);
            PG8_BAR; PG8_WAIT_L(0); PG8_MMA(0, 1, At, B1); PG8_BAR;
            PG8_LDA(At, 0, 1); PG8_STAGE(PG8_SA(0, 0), a2, voffA);
            PG8_BAR; PG8_WAIT_L(0); PG8_MMA(1, 0, At, B0); PG8_BAR; PG8_SCHED;
            PG8_STAGE(PG8_SB(0, 1), b2 + hstep, voffB);
            PG8_WAIT_V(6); PG8_BAR; PG8_MMA(1, 1, At, B1); PG8_BAR;
            PG8_LDB(B0, 1, 0); PG8_SCHED; PG8_LDA(At, 1, 0); PG8_STAGE(PG8_SA(0, 1), a2 + hstep, voffA);
            PG8_WAIT_L(8); PG8_BAR; PG8_WAIT_L(0); PG8_MMA(0, 0, At, B0); PG8_BAR; PG8_SCHED;
            PG8_LDB(B1, 1, 1); PG8_STAGE(PG8_SB(1, 0), b3, voffB);
            PG8_BAR; PG8_WAIT_L(0); PG8_MMA(0, 1, At, B1); PG8_BAR;
            PG8_LDA(At, 1, 1); PG8_STAGE(PG8_SA(1, 0), a3, voffA);
            PG8_BAR; PG8_WAIT_L(0); PG8_MMA(1, 0, At, B0); PG8_BAR; PG8_SCHED;
            PG8_STAGE(PG8_SB(1, 1), b3 + hstep, voffB);
            PG8_WAIT_V(6); PG8_BAR; PG8_MMA(1, 1, At, B1); PG8_BAR;
            }
        }
        if constexpr (ALIGN_EPI) { if (wr == 0) PG8_BAR; }
        if constexpr (!Epi::AFTER_DRAIN) { E(acc, cur, wr, wc, fr, fq); S.done(cur); }
        if (!has_next) break;
#pragma unroll
        for (int a = 0; a < 2; ++a)
#pragma unroll
            for (int b = 0; b < 2; ++b)
#pragma unroll
                for (int m = 0; m < 4; ++m)
#pragma unroll
                    for (int n = 0; n < 2; ++n) acc[a][b][m][n] = (f32x4){0.f, 0.f, 0.f, 0.f};
        cur = nxt; cA = nA; cB = nB; ++ui;
        if constexpr (ALIGN_EPI) { if (wr == 1) PG8_BAR; }
    }
    PG8_WAIT_V(0);
    if constexpr (!ALIGN_EPI) { if (wr == 0) PG8_BAR; }
    PG8_BAR;
    if constexpr (Epi::AFTER_DRAIN) { E.fused(acc, cur, wr, wc, fr, fq, lds, wid, lane); S.done(cur); }
#undef PG8_SA
#undef PG8_SB
#undef PG8_STAGE
#undef PG8_LDA
#undef PG8_LDB
#undef PG8_MMA
#undef PG8_WAIT_V
#undef PG8_WAIT_L
#undef PG8_BAR
#undef PG8_SCHED
}
}
namespace att {
#define ALAS __attribute__((address_space(3)))
constexpr int D = 128, OSTR = 1024;
constexpr float THR = 8.f;
constexpr bool WSKIP = false;
constexpr float SCALE = 0.08838834764831845f;
constexpr int NW = 8, QBLK = 32, KVBLK = 64, QB = NW * QBLK;
constexpr int SHM_V = KVBLK * D * 2, SHM_K = KVBLK * D * 2;
constexpr int CB_FLOATS = 8256;
constexpr int LDS_BYTES = 2 * SHM_V + 2 * SHM_K + NW * 64 * 4 + CB_FLOATS * 4;
using bf16 = __hip_bfloat16;
typedef short bf16x8 __attribute__((ext_vector_type(8)));
typedef short s16x4 __attribute__((ext_vector_type(4)));
typedef float f32x16 __attribute__((ext_vector_type(16)));
typedef float f32x4 __attribute__((ext_vector_type(4)));
typedef unsigned u32x4 __attribute__((ext_vector_type(4)));
template <class A, class Bt> struct same_t { static constexpr bool v = false; };
template <class A> struct same_t<A, A> { static constexpr bool v = true; };
#define KSWZ(row, colB) ((row) * 256 + ((colB) ^ (((row) & 7) << 4)))
#define SBAR() __builtin_amdgcn_sched_barrier(0)
__device__ __forceinline__ int v_st(int k, int c) { const int kk = (k & ~0xC) | ((k & 4) << 1) | ((k & 8) >> 1); return ((kk >> 3) * 4 + (c >> 5)) * 512 + ((kk & 7) * 32 + (c & 31)) * 2; }
__device__ __forceinline__ int v_rd_base(int lane) { return ((lane & 3) << 3) | (((lane >> 2) & 3) << 6) | (((lane >> 4) & 1) << 5) | (((lane >> 5) & 1) << 8); }
constexpr int v_rd_off(int d0, int ks, int half) { return d0 * 512 + ks * 4096 + half * 2048; }
__device__ __forceinline__ int crow(int r, int hi) { return (r & 3) + 8 * (r >> 2) + 4 * hi; }
__device__ __forceinline__ unsigned cvtpk(float lo, float hi) {
    unsigned r; asm volatile("v_cvt_pk_bf16_f32 %0, %1, %2" : "=v"(r) : "v"(lo), "v"(hi)); return r;
}
__device__ __forceinline__ bf16x8 pack8(f32x4 a, f32x4 b) {
    u32x4 w = {cvtpk(a[0], a[1]), cvtpk(a[2], a[3]), cvtpk(b[0], b[1]), cvtpk(b[2], b[3])};
    return *reinterpret_cast<bf16x8*>(&w);
}
template <class T> __device__ __forceinline__ bf16x8 load8(const T* p) {
    if constexpr (same_t<T, float>::v) { return pack8(*(const f32x4*)p, *(const f32x4*)(p + 4)); }
    else { return *reinterpret_cast<const bf16x8*>(p); }
}
__device__ __forceinline__ void mask_tile(f32x16& p0, f32x16& p1, int dq, unsigned W) {
    const float NEG = -__builtin_inff();
#pragma unroll
    for (int r = 0; r < 16; ++r) {
        const int c = (r & 3) + 8 * (r >> 2);
        if ((unsigned)(dq - c) >= W) p0[r] = NEG;
        if ((unsigned)(dq - c - 32) >= W) p1[r] = NEG;
    }
}
__device__ __forceinline__ void partialSM(f32x16& p0, f32x16& p1, float& m_reg, float& mn, float& alpha) {
    float pmax = p0[0]; for (int r = 1; r < 16; ++r) pmax = fmaxf(pmax, p0[r]); for (int r = 0; r < 16; ++r) pmax = fmaxf(pmax, p1[r]);
    { auto rr = __builtin_amdgcn_permlane32_swap(__float_as_uint(pmax), __float_as_uint(pmax), false, false);
      pmax = fmaxf(__uint_as_float(rr[0]), __uint_as_float(rr[1])); }
    constexpr float C2 = 1.4426950408889634f * SCALE;
    if (__builtin_expect(__all((pmax - m_reg) * SCALE <= THR), 1)) { mn = m_reg; alpha = 1.f; }
    else { mn = fmaxf(m_reg, pmax); alpha = __builtin_amdgcn_exp2f((m_reg - mn) * C2); m_reg = mn; }
    const float mnL = -mn * C2;
    for (int r = 0; r < 16; ++r) p0[r] = fmaf(p0[r], C2, mnL); for (int r = 0; r < 16; ++r) p1[r] = fmaf(p1[r], C2, mnL);
    for (int r = 0; r < 16; ++r) p0[r] = __builtin_amdgcn_exp2f(p0[r]);
}
__device__ __forceinline__ void finishSM(f32x16& p0, f32x16& p1, float alpha, float& l_reg, bf16x8& pa0, bf16x8& pa1, bf16x8& pa2, bf16x8& pa3) {
    for (int r = 0; r < 16; ++r) p1[r] = __builtin_amdgcn_exp2f(p1[r]);
    float ps = 0; for (int r = 0; r < 16; ++r) ps += p0[r]; for (int r = 0; r < 16; ++r) ps += p1[r];
    { auto rr = __builtin_amdgcn_permlane32_swap(__float_as_uint(ps), __float_as_uint(ps), false, false);
      ps = __uint_as_float(rr[0]) + __uint_as_float(rr[1]); }
    l_reg = l_reg * alpha + ps;
#define PK4(P, B_, OUT) do { unsigned a0 = cvtpk(P[B_+0], P[B_+1]), a1 = cvtpk(P[B_+2], P[B_+3]);                          \
        unsigned b0 = cvtpk(P[B_+4], P[B_+5]), b1 = cvtpk(P[B_+6], P[B_+7]);                                             \
        auto r0 = __builtin_amdgcn_permlane32_swap(a0, b0, false, false); auto r1 = __builtin_amdgcn_permlane32_swap(a1, b1, false, false); \
        u32x4 w = {r0[0], r1[0], r0[1], r1[1]}; OUT = *reinterpret_cast<bf16x8*>(&w); } while (0)
    PK4(p0, 0, pa0); PK4(p0, 8, pa1); PK4(p1, 0, pa2); PK4(p1, 8, pa3);
#undef PK4
}
template <int KB, bool SK>
__device__ __forceinline__ void qkt(f32x16& p0, f32x16& p1, const char* K_lds, int r32, int hi, const bf16x8* qr, bool act, const ALAS float* cbt) {
    if (SK && !act) { const float NEG = -__builtin_inff();
#pragma unroll
        for (int r = 0; r < 16; ++r) { p0[r] = NEG; p1[r] = NEG; } return; }
#pragma unroll
    for (int g = 0; g < 4; ++g) { const f32x4 ba = *(const ALAS f32x4*)(cbt + 8 * g), bb = *(const ALAS f32x4*)(cbt + 32 + 8 * g);
        p0[4 * g] = ba[0]; p0[4 * g + 1] = ba[1]; p0[4 * g + 2] = ba[2]; p0[4 * g + 3] = ba[3]; p1[4 * g] = bb[0]; p1[4 * g + 1] = bb[1]; p1[4 * g + 2] = bb[2]; p1[4 * g + 3] = bb[3]; }
    const char* kb[4];
#pragma unroll
    for (int dd = 0; dd < 4; ++dd) kb[dd] = K_lds + KB * SHM_K + KSWZ(r32, (dd * 16 + hi * 8) * 2);
#pragma unroll
    for (int d0 = 0; d0 < 8; ++d0) { const char* a = kb[d0 & 3] + (d0 >> 2) * 128;
        bf16x8 b0 = *reinterpret_cast<const bf16x8*>(a);
        bf16x8 b1 = *reinterpret_cast<const bf16x8*>(a + 32 * 256);
        p0 = __builtin_amdgcn_mfma_f32_32x32x16_bf16(b0, qr[d0], p0, 0, 0, 0);
        p1 = __builtin_amdgcn_mfma_f32_32x32x16_bf16(b1, qr[d0], p1, 0, 0, 0); }
}
template <int VB, bool SK>
__device__ __forceinline__ void pv_tile(f32x16* o, int vb0, bf16x8 pa0, bf16x8 pa1, bf16x8 pa2, bf16x8 pa3, bool act) {
    if (SK && !act) return;
#define TRRD(dst, off) asm volatile("ds_read_b64_tr_b16 %0, %1 offset:%2" : "=&v"(dst) : "v"(vb0), "i"(off) : "memory")
#define PV_D0(d0) do { s16x4 l0, l1, l2, l3, h0, h1, h2, h3; constexpr int b_ = VB * SHM_V + v_rd_off(d0, 0, 0);     \
        TRRD(l0, b_); TRRD(h0, b_ + 2048); TRRD(l1, b_ + 4096); TRRD(h1, b_ + 6144); TRRD(l2, b_ + 8192); TRRD(h2, b_ + 10240); TRRD(l3, b_ + 12288); TRRD(h3, b_ + 14336); \
        asm volatile("s_waitcnt lgkmcnt(0)" ::: "memory"); SBAR();                 \
        o[d0] = __builtin_amdgcn_mfma_f32_32x32x16_bf16(pa0, (bf16x8){l0[0], l0[1], l0[2], l0[3], h0[0], h0[1], h0[2], h0[3]}, o[d0], 0, 0, 0);   \
        o[d0] = __builtin_amdgcn_mfma_f32_32x32x16_bf16(pa1, (bf16x8){l1[0], l1[1], l1[2], l1[3], h1[0], h1[1], h1[2], h1[3]}, o[d0], 0, 0, 0);   \
        o[d0] = __builtin_amdgcn_mfma_f32_32x32x16_bf16(pa2, (bf16x8){l2[0], l2[1], l2[2], l2[3], h2[0], h2[1], h2[2], h2[3]}, o[d0], 0, 0, 0);   \
        o[d0] = __builtin_amdgcn_mfma_f32_32x32x16_bf16(pa3, (bf16x8){l3[0], l3[1], l3[2], l3[3], h3[0], h3[1], h3[2], h3[3]}, o[d0], 0, 0, 0); } while (0)
    PV_D0(0); PV_D0(1); PV_D0(2); PV_D0(3);
#undef PV_D0
#undef TRRD
}

template <class TIn, class TOut> struct BlockRef { const TIn* Q; const TIn* K; const TIn* V; TOut* O; const float* CB; int P0; };
template <class TIn> struct Seam {
    bf16x8 qr[8];
    bf16x8 st_v0, st_v1, st_k0, st_k1; f32x4 sf0, sf1, sf2, sf3;
    f32x4 tq[16];
};
__device__ __forceinline__ int swa_jlo(int P0, int W) { const int lowk = P0 - W + 1; return lowk > 0 ? lowk / KVBLK : 0; }
#define ROW(p, k0, rr) ((p) + (size_t)((k0) + (rr)) * D + sc)
#define VMW() asm volatile("s_waitcnt vmcnt(0)" ::: "memory")
#define VMWN(n) asm volatile("s_waitcnt vmcnt(%0)" :: "i"(n) : "memory")
#define SLOAD_H(Kp, Vp, k0) do { S.st_v0 = load8<TIn>(ROW(Vp, k0, sr)); S.st_v1 = load8<TIn>(ROW(Vp, k0, 32 + sr));              \
                         S.st_k0 = load8<TIn>(ROW(Kp, k0, sr)); S.st_k1 = load8<TIn>(ROW(Kp, k0, 32 + sr)); } while (0)
#define SWRITE_HK(bf) do { *(bf16x8*)(K_lds + (bf) * SHM_K + kws) = S.st_k0; *(bf16x8*)(K_lds + (bf) * SHM_K + kws + 32 * 256) = S.st_k1; } while (0)
#define SWRITE_HV(bf) do { *(bf16x8*)(V_lds + (bf) * SHM_V + vst0) = S.st_v0; *(bf16x8*)(V_lds + (bf) * SHM_V + vst1) = S.st_v1; } while (0)
#define SWRITE_H(bf) do { SWRITE_HV(bf); SWRITE_HK(bf); } while (0)
#define SLOAD_F(p, k0) do { S.sf0 = *(const f32x4*)ROW(p, k0, sr); S.sf1 = *(const f32x4*)(ROW(p, k0, sr) + 4);                \
                            S.sf2 = *(const f32x4*)ROW(p, k0, 32 + sr); S.sf3 = *(const f32x4*)(ROW(p, k0, 32 + sr) + 4); } while (0)
#define SWRITE_KF(bf) do { *(bf16x8*)(K_lds + (bf) * SHM_K + kws) = pack8(S.sf0, S.sf1); *(bf16x8*)(K_lds + (bf) * SHM_K + kws + 32 * 256) = pack8(S.sf2, S.sf3); } while (0)
#define SWRITE_VF(bf) do { *(bf16x8*)(V_lds + (bf) * SHM_V + vst0) = pack8(S.sf0, S.sf1); *(bf16x8*)(V_lds + (bf) * SHM_V + vst1) = pack8(S.sf2, S.sf3); } while (0)
template <class TIn, class TOut>
__device__ __forceinline__ void causal_swa_prime(const BlockRef<TIn, TOut>& cur, int W, char* lds, Seam<TIn>& S) {
    constexpr bool F32 = same_t<TIn, float>::v;
    int tid_ = threadIdx.x; asm volatile("" : "+v"(tid_));
    const int tid = tid_, wid = __builtin_amdgcn_readfirstlane(tid >> 6), lane = tid & 63, r32 = lane & 31, hi = lane >> 5;
    const int sr = tid >> 4, sc = (tid & 15) * 8, kws = KSWZ(sr, sc * 2); char* K_lds = lds + 2 * SHM_V;
    const int kb0 = swa_jlo(cur.P0, W) * KVBLK;
    for (int d0 = 0; d0 < 8; ++d0) S.qr[d0] = load8<TIn>(cur.Q + (size_t)(wid * QBLK + r32) * D + d0 * 16 + hi * 8);
    if constexpr (F32) { SLOAD_F((const float*)cur.K, kb0); VMW(); SWRITE_KF(0); SBAR(); SLOAD_F((const float*)cur.V, kb0); }
    else { SLOAD_H(cur.K, cur.V, kb0); VMW(); SWRITE_HK(0); }
    __syncthreads();
}
template <class TIn, class TOut>
__device__ __forceinline__ void causal_swa_block(const BlockRef<TIn, TOut>& cur, const BlockRef<TIn, TOut>& nxt, int skv, int W, char* lds, Seam<TIn>& S) {
    constexpr bool F32 = same_t<TIn, float>::v;
    int tid_ = threadIdx.x; asm volatile("" : "+v"(tid_));
    const int tid = tid_, wid = __builtin_amdgcn_readfirstlane(tid >> 6), lane = tid & 63, r32 = lane & 31, hi = lane >> 5;
    const int j_lo = swa_jlo(cur.P0, W);
    int j_hi = (cur.P0 + QB - 1) / KVBLK + 1; if (j_hi > skv / KVBLK) j_hi = skv / KVBLK;
    const int NT = j_hi - j_lo;
    const int kbn = swa_jlo(nxt.P0, W) * KVBLK;
    const int qlo = cur.P0 + wid * QBLK, qm = qlo + r32 - 4 * hi;
    char* V_lds = lds; char* K_lds = lds + 2 * SHM_V;
    float* ws = (float*)(lds + 2 * SHM_V + 2 * SHM_K) + wid * 64; float* li_l = ws, * al_l = ws + 32;
    float m_reg = -1e30f, l_reg = 0; f32x16 o[4] = {};
    const ALAS float* cbl = (const ALAS float*)(lds + 2 * SHM_V + 2 * SHM_K + NW * 64 * 4);
    { const int nk4 = j_hi * (KVBLK / 4); for (int i = tid; i < nk4; i += 64 * NW) ((ALAS f32x4*)cbl)[i] = ((const f32x4*)cur.CB)[i]; __syncthreads(); }
    const int sr = tid >> 4, sc = (tid & 15) * 8, vst0 = v_st(sr, sc), vst1 = v_st(32 + sr, sc), kws = KSWZ(sr, sc * 2);
    const int vb0 = (int)(uintptr_t)V_lds + v_rd_base(lane);
    const TIn* Kh = cur.K; const TIn* Vh = cur.V;
#define RESC(a) do { if (__any((a) < 1.f)) { if (hi == 0) al_l[r32] = (a); asm volatile("s_waitcnt lgkmcnt(0)" ::: "memory");              \
                     for (int d_ = 0; d_ < 4; ++d_) for (int r = 0; r < 16; ++r) o[d_][r] *= al_l[crow(r, hi)]; } } while (0)
#define KBASE(t) ((j_lo + (t)) * KVBLK)
#define CBT(t) (cbl + KBASE(t) + 4 * hi)
#define ACT(t) (KBASE(t) <= qlo + QBLK - 1 && KBASE(t) + KVBLK - 1 >= qlo - W + 1)
#define MASKT(P0_, P1_, t) do { const int kb_ = KBASE(t); if ((!SK || ACT(t)) && (kb_ + KVBLK - 1 > qlo || kb_ <= qlo + QBLK - 1 - W)) mask_tile(P0_, P1_, qm - kb_, (unsigned)W); } while (0)
    constexpr int NQL = F32 ? 16 : 8;
    constexpr bool SK = WSKIP && !F32;
#define SEAM_K0() do { VMWN(NQL); if constexpr (F32) { SWRITE_KF(0); SBAR(); SLOAD_F((const float*)nxt.V, kbn); } else { SWRITE_HK(0); } SBAR(); } while (0)
    f32x16 pA0, pA1, pB0, pB1; float mnA, mnB, alA, alB; bf16x8 pa0, pa1, pa2, pa3;
    if constexpr (F32) { VMW(); SWRITE_VF(0); SBAR(); } else { SWRITE_HV(0); SBAR(); }
    if (NT > 1) { if constexpr (F32) SLOAD_F((const float*)Kh, KBASE(1)); else SLOAD_H(Kh, Vh, KBASE(1)); }
    SBAR(); qkt<0, SK>(pA0, pA1, K_lds, r32, hi, S.qr, ACT(0), CBT(0));
    if constexpr (F32) { if (NT > 1) { VMW(); SWRITE_KF(1); SBAR(); SLOAD_F((const float*)Vh, KBASE(1)); } }
    MASKT(pA0, pA1, 0); partialSM(pA0, pA1, m_reg, mnA, alA);
    if (NT > 1) { VMW(); if constexpr (F32) { SWRITE_VF(1); SBAR(); if (NT > 2) SLOAD_F((const float*)Kh, KBASE(2)); } else SWRITE_H(1); }
    __syncthreads();
#define HALF_STEP(PX0, PX1, mnX, alX, PY0, PY1, alY, t, KB, VB, SB) do {                                                      \
        SBAR(); qkt<KB, SK>(PX0, PX1, K_lds, r32, hi, S.qr, ACT(t), CBT(t));                                             \
        finishSM(PY0, PY1, alY, l_reg, pa0, pa1, pa2, pa3); SBAR();                                                           \
        if ((t) + 1 < NT) { if constexpr (F32) { VMW(); SWRITE_KF(SB); SBAR(); SLOAD_F((const float*)Vh, KBASE((t) + 1)); }  \
                            else { SLOAD_H(Kh, Vh, KBASE((t) + 1)); } SBAR(); }                                               \
        pv_tile<VB, SK>(o, vb0, pa0, pa1, pa2, pa3, ACT((t) - 1)); MASKT(PX0, PX1, (t)); partialSM(PX0, PX1, m_reg, mnX, alX);                                        \
        __syncthreads();                                                                                                      \
        if ((t) + 1 < NT) { VMW(); if constexpr (F32) { SWRITE_VF(SB); SBAR(); if ((t) + 2 < NT) SLOAD_F((const float*)Kh, KBASE((t) + 2)); } \
                            else { SWRITE_H(SB); } }                                                                          \
        RESC(alX); __syncthreads(); } while (0)
    for (int t = 1; t + 1 < NT; t += 2) {
        HALF_STEP(pB0, pB1, mnB, alB, pA0, pA1, alA, t, 1, 0, 0);
        HALF_STEP(pA0, pA1, mnA, alA, pB0, pB1, alB, t + 1, 0, 1, 1);
    }
    const bool even = (NT & 1) == 0;
    if (even) { SBAR(); qkt<1, SK>(pB0, pB1, K_lds, r32, hi, S.qr, ACT(NT - 1), CBT(NT - 1)); SBAR(); }
#define QROW(e) (nxt.Q + (size_t)(wid * QBLK + r32) * D + ((e) >> 1) * 16 + hi * 8 + ((e) & 1) * 4)
    if constexpr (F32) { SLOAD_F((const float*)nxt.K, kbn); SBAR();
#pragma unroll
        for (int e = 0; e < 8; ++e) S.tq[e] = *(const f32x4*)QROW(e); }
    else { SLOAD_H(nxt.K, nxt.V, kbn); SBAR();
#pragma unroll
        for (int d0 = 0; d0 < 8; ++d0) S.qr[d0] = load8<TIn>(nxt.Q + (size_t)(wid * QBLK + r32) * D + d0 * 16 + hi * 8); }
    SBAR();
    finishSM(pA0, pA1, alA, l_reg, pa0, pa1, pa2, pa3); SBAR();
    if constexpr (F32) {
#pragma unroll
        for (int e = 8; e < 16; ++e) S.tq[e] = *(const f32x4*)QROW(e); SBAR(); }
#undef QROW
    pv_tile<0, SK>(o, vb0, pa0, pa1, pa2, pa3, ACT(even ? NT - 2 : NT - 1));
    if (even) { MASKT(pB0, pB1, NT - 1); partialSM(pB0, pB1, m_reg, mnB, alB); __syncthreads(); RESC(alB);
        finishSM(pB0, pB1, alB, l_reg, pa0, pa1, pa2, pa3); SBAR(); pv_tile<1, SK>(o, vb0, pa0, pa1, pa2, pa3, ACT(NT - 1)); }
    SBAR(); SEAM_K0();
    if (hi == 0) li_l[r32] = l_reg; asm volatile("s_waitcnt lgkmcnt(0)" ::: "memory");
    float rli[16];
#pragma unroll
    for (int r = 0; r < 16; ++r) rli[r] = __builtin_amdgcn_rcpf(li_l[crow(r, hi)]);
    TOut* Ow = cur.O + (size_t)(wid * QBLK) * OSTR;
#pragma unroll
    for (int r = 0; r < 16; ++r) { const int orow = crow(r, hi);
#pragma unroll
        for (int d0 = 0; d0 < 4; ++d0) { const float v = o[d0][r] * rli[r];
            if constexpr (same_t<TOut, float>::v) { Ow[(size_t)orow * OSTR + d0 * 32 + r32] = v; }
            else { const float vn = __shfl_xor(v, 1);
                   if ((r32 & 1) == 0) *(unsigned*)(Ow + (size_t)orow * OSTR + d0 * 32 + r32) = cvtpk(v, vn); } } }
    if constexpr (F32) {
#pragma unroll
        for (int d0 = 0; d0 < 8; ++d0) S.qr[d0] = pack8(S.tq[2 * d0], S.tq[2 * d0 + 1]); }
    __syncthreads();
#undef RESC
#undef KBASE
#undef CBT
#undef ACT
#undef MASKT
#undef SEAM_K0
#undef HALF_STEP
}
#undef ROW
#undef VMW
#undef VMWN
#undef SLOAD_H
#undef SWRITE_HK
#undef SWRITE_HV
#undef SWRITE_H
#undef SLOAD_F
#undef SWRITE_KF
#undef SWRITE_VF

#undef KSWZ
#undef SBAR
}

#define LAS __attribute__((address_space(3)))
typedef unsigned short bf16;
typedef float f32x4 __attribute__((ext_vector_type(4)));
typedef unsigned u32x4 __attribute__((ext_vector_type(4)));
typedef unsigned u32x2 __attribute__((ext_vector_type(2)));
constexpr int NWAVES = 8, NTHR = 512;
constexpr int DM = 1024, FF = 2816, TOK = 16384, MT = 16640, NMETA = 16, SEQ = 8192, NH = 8, KVPOS = 8256;
constexpr float LN_EPS = 1e-5f;
constexpr size_t MiB = 1u << 20;
constexpr size_t UPSZ = (size_t)2 * FF * DM, DNSZ = (size_t)DM * FF, SQ = (size_t)DM * DM;
constexpr size_t W_UP10 = 0, W_DN10 = W_UP10 + UPSZ, W_UP20 = W_DN10 + DNSZ, W_DN20 = W_UP20 + UPSZ, W_CIN = W_DN20 + DNSZ, W_COUT = W_CIN + 3 * SQ, W_KV = W_COUT + SQ,
                 W_UP11 = W_KV + 2 * SQ, W_DN11 = W_UP11 + UPSZ, W_UP21 = W_DN11 + DNSZ, W_DN21 = W_UP21 + UPSZ, W_Q = W_DN21 + DNSZ, W_O = W_Q + SQ, W_END = W_O + SQ;
constexpr size_t WS_W = 1 * MiB, WS_HB = 84 * MiB, WS_BIG = 117 * MiB, WS_V = 207 * MiB, WS_XM = 240 * MiB, WS_FLOG = 241 * MiB, WS_CB = 242 * MiB, WS_END = 243 * MiB;
static_assert(WS_W + W_END * 2 <= WS_HB && WS_HB + (size_t)MT * DM * 2 <= WS_BIG && WS_BIG + (size_t)MT * FF * 2 <= WS_V && WS_V + (size_t)2 * NH * KVPOS * 128 * 2 <= WS_XM, "ws map");
static_assert((size_t)2 * NH * KVPOS * 128 * 2 <= W_CIN * 2, "K overlay fits in the dead layer-0 FFN weights");
static_assert((size_t)(MT + NMETA) * NH * 4 <= MiB && (size_t)2 * NH * KVPOS * 4 <= MiB && (size_t)256 * DM * 4 <= MiB, "small buffers");
constexpr int LDS_TOTAL = 131072;
static_assert(att::LDS_BYTES <= LDS_TOTAL && pg8::STAGE_BYTES <= LDS_TOTAL, "LDS");

struct Args { const float* in[17]; float* out; unsigned char* ws; };

__device__ __forceinline__ unsigned pk2(float lo, float hi) { return pg8::cvt_pk_bf16(lo, hi); }
__device__ __forceinline__ float wave_sum(float v) {
#pragma unroll
    for (int o = 1; o < 64; o <<= 1) v += __shfl_xor(v, o);
    return v;
}
__device__ __forceinline__ void tr_item(const float* W, int ldw, int K, int k0, int n0, bf16* WTrow0, LAS float* scr, int lane) {
#pragma unroll 8
    for (int i = 0; i < 32; ++i) { const int kk = 2 * i + (lane >> 5); scr[kk * 33 + (lane & 31)] = W[(size_t)(k0 + kk) * ldw + n0 + (lane & 31)]; }
    asm volatile("s_waitcnt lgkmcnt(0)" ::: "memory");
    const int c = lane & 7;
#pragma unroll
    for (int j = 0; j < 4; ++j) { const int n = (lane >> 3) + 8 * j; const LAS float* s = scr + (8 * c) * 33 + n;
        u32x4 o; o.x = pk2(s[0 * 33], s[1 * 33]); o.y = pk2(s[2 * 33], s[3 * 33]); o.z = pk2(s[4 * 33], s[5 * 33]); o.w = pk2(s[6 * 33], s[7 * 33]);
        *(u32x4*)(WTrow0 + (size_t)n * K + k0 + 8 * c) = o; }
    asm volatile("s_waitcnt lgkmcnt(0)" ::: "memory");
}
__device__ __forceinline__ int drow(int kind, int n0) {
    if (kind == 0) return n0;
    if (kind == 1) return (n0 >> 7) * 256 + (n0 & 127);
    if (kind == 2) return (n0 >> 7) * 256 + 128 + (n0 & 127);
    if (n0 < 1024) return 2048 + n0;
    if (n0 < 2048) { const int j = n0 - 1024; return (j >> 7) * 256 + (j & 127); }
    { const int j = n0 - 2048; return (j >> 7) * 256 + 128 + (j & 127); }
}
#define TR_TRY(Wp, ldw_, K_, N_, dst_, kind_) { const int cnt_ = ((K_) / 64) * ((N_) / 32); if (r < cnt_) { const int nblk_ = (N_) / 32, kb_ = r / nblk_, n0_ = (r % nblk_) * 32; \
        tr_item((Wp), (ldw_), (K_), kb_ * 64, n0_, (dst_) + (size_t)drow((kind_), n0_) * (K_), scr, lane); continue; } r -= cnt_; }
__device__ __forceinline__ void p0_prologue(const Args& a, LAS unsigned char* lds, int vcu, int G) {
    int tid_ = threadIdx.x; asm volatile("" : "+v"(tid_)); const int lane = tid_ & 63, wave = __builtin_amdgcn_readfirstlane(tid_ >> 6); (void)lane; (void)wave;
    const int gw = vcu * NWAVES + wave, NGW = G * NWAVES, gtid = blockIdx.x * NTHR + tid_, NGT = G * NTHR;
    bf16* WT = (bf16*)(a.ws + WS_W);
    LAS float* scr = (LAS float*)(lds + wave * 16384);
    constexpr int I_UP = (DM / 64) * (FF / 32), I_DN = (FF / 64) * (DM / 32), I_SQ = (DM / 64) * (DM / 32);
    constexpr int NITEMS = 8 * I_UP + 4 * I_DN + 3 * I_SQ + 2 * I_SQ + 3 * I_SQ;
    for (int it = gw; it < NITEMS; it += NGW) {
        int r = it;
        TR_TRY(a.in[2], FF, DM, FF, WT + W_UP10, 1) TR_TRY(a.in[3], FF, DM, FF, WT + W_UP10, 2) TR_TRY(a.in[4], DM, FF, DM, WT + W_DN10, 0)
        TR_TRY(a.in[5], FF, DM, FF, WT + W_UP20, 1) TR_TRY(a.in[6], FF, DM, FF, WT + W_UP20, 2) TR_TRY(a.in[7], DM, FF, DM, WT + W_DN20, 0)
        TR_TRY(a.in[10], 3 * DM, DM, 3 * DM, WT + W_CIN, 3) TR_TRY(a.in[12], DM, DM, DM, WT + W_COUT, 0) TR_TRY(a.in[13], 2 * DM + NH, DM, 2 * DM, WT + W_KV, 0)
        TR_TRY(a.in[2] + (size_t)DM * FF, FF, DM, FF, WT + W_UP11, 1) TR_TRY(a.in[3] + (size_t)DM * FF, FF, DM, FF, WT + W_UP11, 2) TR_TRY(a.in[4] + (size_t)DM * FF, DM, FF, DM, WT + W_DN11, 0)
        TR_TRY(a.in[5] + (size_t)DM * FF, FF, DM, FF, WT + W_UP21, 1) TR_TRY(a.in[6] + (size_t)DM * FF, FF, DM, FF, WT + W_UP21, 2) TR_TRY(a.in[7] + (size_t)DM * FF, DM, FF, DM, WT + W_DN21, 0)
        TR_TRY(a.in[15], DM, DM, DM, WT + W_Q, 0) TR_TRY(a.in[16], DM, DM, DM, WT + W_O, 0)
    }
    bf16* hb = (bf16*)(a.ws + WS_HB); const float* x = a.in[0];
    for (int idx = gtid; idx < TOK * 128; idx += NGT) { const f32x4 v0 = *(const f32x4*)(x + (size_t)idx * 8), v1 = *(const f32x4*)(x + (size_t)idx * 8 + 4);
        *(u32x4*)(hb + (size_t)idx * 8) = pg8::pack8(v0, v1); }
    float* Xm = (float*)(a.ws + WS_XM); const float* meta = a.in[1];
    for (int idx = gtid; idx < 256 * 128; idx += NGT) { const int row = idx >> 7; f32x4 v0 = {0.f, 0.f, 0.f, 0.f}, v1 = v0;
        if (row < NMETA) { v0 = *(const f32x4*)(meta + (size_t)idx * 8); v1 = *(const f32x4*)(meta + (size_t)idx * 8 + 4); }
        *(f32x4*)(Xm + (size_t)idx * 8) = v0; *(f32x4*)(Xm + (size_t)idx * 8 + 4) = v1; *(u32x4*)(hb + (size_t)TOK * DM + (size_t)idx * 8) = pg8::pack8(v0, v1); }
    bf16* Vb = (bf16*)(a.ws + WS_V);
    for (int idx = gtid; idx < 16 * 48 * 16; idx += NGT) { const int bh = idx / (48 * 16), rem = idx % (48 * 16);
        *(u32x4*)(Vb + ((size_t)bh * KVPOS + 8208) * 128 + (size_t)rem * 8) = (u32x4){0u, 0u, 0u, 0u}; }
}
template <bool HB, bool FLOG>
__device__ __forceinline__ void ln_phase(const Args& a, LAS unsigned char* lds, int nrows, const float* gain, const float* beta, int vcu, int G) {
    int tid_ = threadIdx.x; asm volatile("" : "+v"(tid_)); const int lane = tid_ & 63, wave = __builtin_amdgcn_readfirstlane(tid_ >> 6); (void)lane; (void)wave;
    const int gw = vcu * NWAVES + wave, NGW = G * NWAVES;
    float* Xt = a.out; float* Xm = (float*)(a.ws + WS_XM); bf16* hb = (bf16*)(a.ws + WS_HB); float* flog = (float*)(a.ws + WS_FLOG);
    LAS float* wfl = (LAS float*)lds;
    if (FLOG) { const float* kvw = a.in[13];
        for (int k = tid_; k < DM; k += NTHR) { const f32x4 w0 = *(const f32x4*)(kvw + (size_t)k * (2 * DM + NH) + 2 * DM), w1 = *(const f32x4*)(kvw + (size_t)k * (2 * DM + NH) + 2 * DM + 4);
            wfl[0 * DM + k] = w0[0]; wfl[1 * DM + k] = w0[1]; wfl[2 * DM + k] = w0[2]; wfl[3 * DM + k] = w0[3]; wfl[4 * DM + k] = w1[0]; wfl[5 * DM + k] = w1[1]; wfl[6 * DM + k] = w1[2]; wfl[7 * DM + k] = w1[3]; }
        __syncthreads(); }
    f32x4 g[4], bt[4];
#pragma unroll
    for (int j = 0; j < 4; ++j) { g[j] = *(const f32x4*)(gain + 4 * lane + 256 * j); bt[j] = *(const f32x4*)(beta + 4 * lane + 256 * j); }
    for (int row = gw; row < nrows; row += NGW) {
        float* xr = (row < TOK) ? Xt + (size_t)row * DM : Xm + (size_t)(row - TOK) * DM;
        f32x4 v[4]; float s = 0.f;
#pragma unroll
        for (int j = 0; j < 4; ++j) { v[j] = *(const f32x4*)(xr + 4 * lane + 256 * j); s += (v[j][0] + v[j][1]) + (v[j][2] + v[j][3]); }
        const float mean = wave_sum(s) * (1.f / DM); float s2 = 0.f;
#pragma unroll
        for (int j = 0; j < 4; ++j) { v[j] = v[j] - mean; s2 += (v[j][0] * v[j][0] + v[j][1] * v[j][1]) + (v[j][2] * v[j][2] + v[j][3] * v[j][3]); }
        const float rstd = 1.f / sqrtf(wave_sum(s2) * (1.f / DM) + LN_EPS);
#pragma unroll
        for (int j = 0; j < 4; ++j) { v[j] = v[j] * rstd * g[j] + bt[j]; *(f32x4*)(xr + 4 * lane + 256 * j) = v[j];
            if (HB) { u32x2 w; w.x = pk2(v[j][0], v[j][1]); w.y = pk2(v[j][2], v[j][3]); *(u32x2*)(hb + (size_t)row * DM + 4 * lane + 256 * j) = w; } }
        if (FLOG) { float myv = 0.f;
#pragma unroll
            for (int h = 0; h < NH; ++h) { float d = 0.f;
#pragma unroll
                for (int j = 0; j < 4; ++j) { const f32x4 w = *(const LAS f32x4*)(wfl + h * DM + 4 * lane + 256 * j); d += (v[j][0] * w[0] + v[j][1] * w[1]) + (v[j][2] * w[2] + v[j][3] * w[3]); }
                d = wave_sum(d); if (lane == h) myv = d; }
            if (lane < NH) { const float z = myv + a.in[14][lane]; const float ls = fminf(z, 0.f) - log1pf(expf(-fabsf(z))); flog[(size_t)row * NH + lane] = ls; } }
    }
    if (FLOG) __syncthreads();
}
__device__ __forceinline__ f32x4 bflo(u32x4 w, int half) { const unsigned a = half ? w.z : w.x, b = half ? w.w : w.y;
    return (f32x4){__uint_as_float(a << 16), __uint_as_float(a & 0xffff0000u), __uint_as_float(b << 16), __uint_as_float(b & 0xffff0000u)}; }
__device__ __forceinline__ void conv_phase(const Args& a, int G) {
    int tid_ = threadIdx.x; asm volatile("" : "+v"(tid_)); const int lane = tid_ & 63, wave = __builtin_amdgcn_readfirstlane(tid_ >> 6); (void)lane; (void)wave;
    const int gtid = blockIdx.x * NTHR + tid_, NGT = G * NTHR;
    bf16* ub = (bf16*)(a.ws + WS_BIG); bf16* bb = ub + (size_t)MT * DM; const float* cw = a.in[11];
    constexpr int NGRP = TOK / 8 + 2;
    for (int item = gtid; item < NGRP * 128; item += NGT) { const int ch = item & 127, rg = item >> 7;
        int b, p0; if (rg < TOK / 8) { b = rg >> 10; p0 = 16 + (rg & 1023) * 8; } else { b = 0; p0 = (rg - TOK / 8) * 8; }
        const f32x4 w0a = *(const f32x4*)(cw + ch * 8), w0b = *(const f32x4*)(cw + ch * 8 + 4), w1a = *(const f32x4*)(cw + DM + ch * 8), w1b = *(const f32x4*)(cw + DM + ch * 8 + 4),
                    w2a = *(const f32x4*)(cw + 2 * DM + ch * 8), w2b = *(const f32x4*)(cw + 2 * DM + ch * 8 + 4);
        u32x4 um2 = {0u, 0u, 0u, 0u}, um1 = um2;
#define UROW(p) ((p) < 16 ? (size_t)(TOK + (p)) : (size_t)(b * SEQ + (p) - 16))
        if (p0 - 2 >= 0) um2 = *(const u32x4*)(ub + UROW(p0 - 2) * DM + ch * 8);
        if (p0 - 1 >= 0) um1 = *(const u32x4*)(ub + UROW(p0 - 1) * DM + ch * 8);
#pragma unroll
        for (int i = 0; i < 8; ++i) { const size_t ro = UROW(p0 + i) * DM + ch * 8;
            const u32x4 u0 = *(const u32x4*)(ub + ro), bg = *(const u32x4*)(bb + ro);
            const f32x4 ya = w0a * bflo(um2, 0) + w1a * bflo(um1, 0) + w2a * bflo(u0, 0), yb = w0b * bflo(um2, 1) + w1b * bflo(um1, 1) + w2b * bflo(u0, 1);
            *(u32x4*)(bb + ro) = pg8::pack8(bflo(bg, 0) * ya, bflo(bg, 1) * yb);
            um2 = um1; um1 = u0; }
#undef UROW
    }
}
__device__ __forceinline__ void scan_bh(const Args& a, LAS unsigned char* lds, int bh) {
    const float* flog = (const float*)(a.ws + WS_FLOG); float* cb = (float*)(a.ws + WS_CB) + (size_t)bh * KVPOS;
    int tid_ = threadIdx.x; asm volatile("" : "+v"(tid_));
    const int b = bh >> 3, h = bh & 7, tid = tid_, lane = tid & 63, wave = tid >> 6; LAS float* wtot = (LAS float*)lds;
    constexpr int PER = 17; float v[PER]; float s = 0.f;
#pragma unroll
    for (int i = 0; i < PER; ++i) { const int p = tid * PER + i; float x = 0.f;
        if (p < SEQ + NMETA) { const size_t row = p < 16 ? (size_t)(TOK + p) : (size_t)(b * SEQ + p - 16); x = flog[row * NH + h]; }
        s += x; v[i] = s; }
    float incl = s;
#pragma unroll
    for (int o = 1; o < 64; o <<= 1) { const float t = __shfl_up(incl, o); if (lane >= o) incl += t; }
    if (lane == 63) wtot[wave] = incl;
    __syncthreads();
    float base = incl - s;
    for (int w = 0; w < wave; ++w) base += wtot[w];
    const float NS = -11.313708498984761f;
#pragma unroll
    for (int i = 0; i < PER; ++i) { const int p = tid * PER + i; if (p < KVPOS) cb[p] = (p < SEQ + NMETA) ? NS * (base + v[i]) : 0.f; }
    __syncthreads();
}
typedef att::BlockRef<att::bf16, att::bf16> ABlock;
__device__ __forceinline__ ABlock att_ref(const Args& a, int L, int pass) {
    const int bh = L >> 4, x = L & 15, qb = pass ? 31 - x : x, b = bh >> 3, h = bh & 7;
    const att::bf16* Q = (const att::bf16*)(a.ws + WS_BIG); att::bf16* O = (att::bf16*)(a.ws + WS_BIG + 32 * MiB);
    const att::bf16* K = (const att::bf16*)(a.ws + WS_W); const att::bf16* V = (const att::bf16*)(a.ws + WS_V);
    ABlock r; r.Q = Q + ((size_t)bh * SEQ + (size_t)qb * 256) * 128; r.K = K + (size_t)bh * KVPOS * 128; r.V = V + (size_t)bh * KVPOS * 128;
    r.O = O + ((size_t)b * SEQ + (size_t)qb * 256) * DM + h * 128; r.CB = (const float*)(a.ws + WS_CB) + (size_t)bh * KVPOS; r.P0 = NMETA + qb * 256;
    return r;
}
__device__ __forceinline__ void attn_phase(const Args& a, char* lds, int vcu, int G) {
    constexpr int total = 256, W = 1 << 30;
    int L = vcu; if (L >= total) return;
    int pass = 0; ABlock cur = att_ref(a, L, 0);
    att::Seam<att::bf16> S;
    att::causal_swa_prime<att::bf16, att::bf16>(cur, W, lds, S);
    for (;;) {
        const bool more_pass = pass == 0, more_item = L + G < total, last = !more_pass && !more_item;
        int passn = pass + 1, Ln = L;
        if (!more_pass) { passn = 0; Ln = more_item ? L + G : L; }
        const ABlock nxt = last ? cur : att_ref(a, Ln, passn);
        att::causal_swa_block<att::bf16, att::bf16>(cur, nxt, KVPOS, W, lds, S);
        if (last) break;
        cur = nxt; pass = passn; L = Ln;
    }
}

__global__ void __launch_bounds__(NTHR, 2) yoco_fwd(Args a) {
    extern __shared__ __attribute__((aligned(16))) unsigned char lds_raw[];
    cg::grid_group grid = cg::this_grid();
    LAS unsigned char* lds = (LAS unsigned char*)lds_raw;
    const int G = gridDim.x, bx = blockIdx.x, vcu = (G % 8 == 0) ? (bx % 8) * (G / 8) + bx / 8 : bx;
    bf16* WT = (bf16*)(a.ws + WS_W); bf16* hb = (bf16*)(a.ws + WS_HB); bf16* big = (bf16*)(a.ws + WS_BIG);
    float* Xm = (float*)(a.ws + WS_XM);
    const float* lng = a.in[8]; const float* lnb = a.in[9];
#define GEMM(EpiT, E_, A_, B_, M_, N_, K_) do { pg8::Gemm g_{(A_), (B_), (M_), (N_), (K_)}; pg8::StaticOrder S_; S_.init((M_), (N_), G, bx); \
        pg8::gemm_phase<EpiT, pg8::StaticOrder, true, true>(lds, g_, S_, (E_)); } while (0)

    p0_prologue(a, lds, vcu, G);
    grid.sync();
    { pg8::EpiSwiglu E{big, FF}; GEMM(pg8::EpiSwiglu, E, hb, WT + W_UP10, MT, 2 * FF, DM); }
    grid.sync();
    { pg8::EpiResid E{a.in[0], a.out, Xm, Xm, 0.5f}; GEMM(pg8::EpiResid, E, big, WT + W_DN10, MT, DM, FF); }
    grid.sync();
    ln_phase<true, false>(a, lds, TOK + NMETA, lng + 0 * DM, lnb + 0 * DM, vcu, G);
    grid.sync();
    { pg8::EpiConvIn E{big, big + (size_t)MT * DM}; GEMM(pg8::EpiConvIn, E, hb, WT + W_CIN, MT, 3 * DM, DM); }
    grid.sync();
    conv_phase(a, G);
    grid.sync();
    { pg8::EpiResid E{a.out, a.out, Xm, Xm, 1.0f}; GEMM(pg8::EpiResid, E, big + (size_t)MT * DM, WT + W_COUT, MT, DM, DM); }
    grid.sync();
    ln_phase<true, false>(a, lds, TOK + NMETA, lng + 1 * DM, lnb + 1 * DM, vcu, G);
    grid.sync();
    { pg8::EpiSwiglu E{big, FF}; GEMM(pg8::EpiSwiglu, E, hb, WT + W_UP20, MT, 2 * FF, DM); }
    grid.sync();
    { pg8::EpiResid E{a.out, a.out, Xm, Xm, 0.5f}; GEMM(pg8::EpiResid, E, big, WT + W_DN20, MT, DM, FF); }
    grid.sync();
    ln_phase<true, true>(a, lds, TOK + NMETA, lng + 2 * DM, lnb + 2 * DM, vcu, G);
    grid.sync();
    { pg8::EpiKV E{WT  , (bf16*)(a.ws + WS_V)}; GEMM(pg8::EpiKV, E, hb, WT + W_KV, MT, 2 * DM, DM); }
    { pg8::EpiSwiglu E{big, FF}; GEMM(pg8::EpiSwiglu, E, hb, WT + W_UP11, TOK, 2 * FF, DM); }
    for (int bh = G - 1 - bx; bh < 2 * NH; bh += G) scan_bh(a, lds, bh);
    grid.sync();
    { pg8::EpiResid E{a.out, a.out, Xm, Xm, 0.5f}; GEMM(pg8::EpiResid, E, big, WT + W_DN11, TOK, DM, FF); }
    grid.sync();
    ln_phase<true, false>(a, lds, TOK, lng + 3 * DM, lnb + 3 * DM, vcu, G);
    grid.sync();
    { pg8::EpiQ E{big}; GEMM(pg8::EpiQ, E, hb, WT + W_Q, TOK, DM, DM); }
    grid.sync();
    attn_phase(a, (char*)lds_raw, vcu, G);
    grid.sync();
    { pg8::EpiResid E{a.out, a.out, Xm, Xm, 1.0f}; GEMM(pg8::EpiResid, E, big + (size_t)16 * MiB  , WT + W_O, TOK, DM, DM); }
    grid.sync();
    ln_phase<true, false>(a, lds, TOK, lng + 4 * DM, lnb + 4 * DM, vcu, G);
    grid.sync();
    { pg8::EpiSwiglu E{big, FF}; GEMM(pg8::EpiSwiglu, E, hb, WT + W_UP21, TOK, 2 * FF, DM); }
    grid.sync();
    { pg8::EpiResid E{a.out, a.out, Xm, Xm, 0.5f}; GEMM(pg8::EpiResid, E, big, WT + W_DN21, TOK, DM, FF); }
    grid.sync();
    ln_phase<false, false>(a, lds, TOK, lng + 5 * DM, lnb + 5 * DM, vcu, G);
#undef GEMM
}

extern "C" void kernel_launch(void* const* d_in, const int* in_sizes, int n_in, void* d_out, int out_size, void* d_ws, size_t ws_size, hipStream_t stream) {
    static int grid = 0;
    if (grid == 0) {
        if (n_in != 17 || in_sizes[0] != TOK * DM || out_size != TOK * DM || ws_size < WS_END) {
            fprintf(stderr, "kernel_launch: unexpected shapes (n_in %d, in0 %d, out %d, ws %zu); nothing launched\n", n_in, n_in > 0 ? in_sizes[0] : -1, out_size, ws_size); grid = -1; return; }
        int dev = 0, cus = 0, per_cu = 0;
        (void)hipGetDevice(&dev); (void)hipDeviceGetAttribute(&cus, hipDeviceAttributeMultiprocessorCount, dev);
        if (hipFuncSetAttribute((const void*)yoco_fwd, hipFuncAttributeMaxDynamicSharedMemorySize, LDS_TOTAL) != hipSuccess) { fprintf(stderr, "kernel_launch: hipFuncSetAttribute failed\n"); grid = -1; return; }
        if (hipOccupancyMaxActiveBlocksPerMultiprocessor(&per_cu, (const void*)yoco_fwd, NTHR, LDS_TOTAL) != hipSuccess || per_cu < 1) { fprintf(stderr, "kernel_launch: occupancy query says %d blocks/CU\n", per_cu); grid = -1; return; }
        grid = cus;
    }
    if (grid < 0) return;
    Args a{};
    for (int i = 0; i < 17; ++i) a.in[i] = (const float*)d_in[i];
    a.out = (float*)d_out; a.ws = (unsigned char*)d_ws;
    void* args[] = {&a};
    hipError_t e = hipLaunchCooperativeKernel((const void*)yoco_fwd, dim3(grid), dim3(NTHR), args, LDS_TOTAL, stream);
    if (e != hipSuccess) fprintf(stderr, "kernel_launch: cooperative launch failed: %s (grid %d)\n", hipGetErrorString(e), grid);
}
```

```cpp
#include <hip/hip_runtime.h>
#include <hip/hip_bf16.h>
#include <hip/hip_cooperative_groups.h>
#include <cstdio>
#include <cstdint>
namespace cg = cooperative_groups;

namespace pg8 {
#define PG8_LAS __attribute__((address_space(3)))
typedef unsigned short bf16_t;
typedef short bf16x8 __attribute__((ext_vector_type(8)));
typedef float f32x4 __attribute__((ext_vector_type(4)));
typedef unsigned u32x4 __attribute__((ext_vector_type(4)));
constexpr int BM = 256, BK = 64, HALF = 128, HTB = HALF * BK * 2  , STAGE_BYTES = 8 * HTB, NXCD = 8, WGM = 8;

__host__ __device__ __forceinline__ int lds_byte(int r, int c) { const int st = (r >> 4) * 2 + (c >> 5), rr = r & 15, cc = c & 31, ob = rr * 64 + cc * 2; return st * 1024 + (ob ^ (((ob >> 9) & 1) << 5)); }
__host__ __device__ __forceinline__ void stage_rc(int b, int& R, int& C) { const int st = b / 1024, sb = b % 1024, swz = sb ^ (((sb >> 9) & 1) << 5); R = (st >> 1) * 16 + swz / 64; C = (st & 1) * 32 + (swz % 64) / 2; }
__host__ __device__ __forceinline__ int perm32(int rho) { const int n = rho >> 4, i = rho & 15; return 8 * (i >> 2) + 4 * n + (i & 3); }

struct Unit { int pm, pn; };
struct Gemm { const bf16_t* A; const bf16_t* Bt; int M, N, K; };

struct StaticOrder {
    int nM, nN, nwg, G, c;
    __host__ __device__ void init(int M, int N, int G_, int c_) { nM = M / BM; nN = N / BM; nwg = nM * nN; G = G_; c = c_; }
    __host__ __device__ bool next(int i, Unit& u) const {
        const long L = (long)i * G + c; if (L >= nwg) return false;
        int wgid = (int)L; { const int q = nwg / NXCD, r = nwg % NXCD, xcd = wgid % NXCD, off = wgid / NXCD; wgid = (xcd < r ? xcd * (q + 1) : r * (q + 1) + (xcd - r) * q) + off; }
        const int nig = WGM * nN, gid = wgid / nig, fm = gid * WGM, gsz = (nM - fm) < WGM ? (nM - fm) : WGM;
        u.pm = fm + ((wgid % nig) % gsz); u.pn = (wgid % nig) / gsz; return true;
    }
    __device__ __forceinline__ void a_ready(const Unit&) const {}
    __device__ __forceinline__ void done(const Unit&) const {}
};
__device__ __forceinline__ unsigned cvt_pk_bf16(float lo, float hi) { unsigned r; asm volatile("v_cvt_pk_bf16_f32 %0, %1, %2" : "=v"(r) : "v"(lo), "v"(hi)); return r; }
__device__ __forceinline__ u32x4 pack8(f32x4 a, f32x4 b) { u32x4 w; w.x = cvt_pk_bf16(a[0], a[1]); w.y = cvt_pk_bf16(a[2], a[3]); w.z = cvt_pk_bf16(b[0], b[1]); w.w = cvt_pk_bf16(b[2], b[3]); return w; }
__device__ __forceinline__ float silu_mul(float g, float u) { return g * __builtin_amdgcn_rcpf(1.0f + __builtin_amdgcn_exp2f(-1.4426950408889634f * g)) * u; }
__device__ __forceinline__ f32x4 silu_mul4(f32x4 g, f32x4 u) { return (f32x4){silu_mul(g[0], u[0]), silu_mul(g[1], u[1]), silu_mul(g[2], u[2]), silu_mul(g[3], u[3])}; }
constexpr int TOKROWS = 16384;
struct EpiSwiglu {
    static constexpr bool PERM = true, AFTER_DRAIN = false;
    bf16_t* act; int ldc;
    __device__ __forceinline__ void operator()(const f32x4 (&acc)[2][2][4][2], const Unit& u, int wr, int wc, int fr, int fq) const {
        const int row0 = u.pm * BM + wr * 64 + fr, col = u.pn * 128 + wc * 32 + 8 * fq;
#pragma unroll
        for (int ai = 0; ai < 2; ++ai)
#pragma unroll
            for (int m = 0; m < 4; ++m) { bf16_t* p = act + (size_t)(row0 + ai * HALF + m * 16) * ldc + col;
                *(u32x4*)p = pack8(silu_mul4(acc[ai][0][m][0], acc[ai][1][m][0]), silu_mul4(acc[ai][0][m][1], acc[ai][1][m][1])); }
    }
};
struct EpiResid {
    static constexpr bool PERM = true, AFTER_DRAIN = false;
    const float* src; float* dst; const float* src_m; float* dst_m; float scale;
    __device__ __forceinline__ void operator()(const f32x4 (&acc)[2][2][4][2], const Unit& u, int wr, int wc, int fr, int fq) const {
        const bool meta = u.pm * BM >= TOKROWS;
        const float* s = meta ? src_m : src + (size_t)u.pm * BM * 1024; float* d = meta ? dst_m : dst + (size_t)u.pm * BM * 1024;
        const int r0 = wr * 64 + fr, c0 = u.pn * BM + wc * 32 + 8 * fq; const float ALPHA = 1.4142135623730951f;
#pragma unroll
        for (int ai = 0; ai < 2; ++ai)
#pragma unroll
            for (int m = 0; m < 4; ++m)
#pragma unroll
                for (int bj = 0; bj < 2; ++bj) { const size_t off = (size_t)(r0 + ai * HALF + m * 16) * 1024 + c0 + bj * HALF;
                    const f32x4 a0 = *(const f32x4*)(s + off), a1 = *(const f32x4*)(s + off + 4);
                    *(f32x4*)(d + off) = a0 * ALPHA + acc[ai][bj][m][0] * scale; *(f32x4*)(d + off + 4) = a1 * ALPHA + acc[ai][bj][m][1] * scale; }
    }
};
struct EpiConvIn {
    static constexpr bool PERM = true, AFTER_DRAIN = false;
    bf16_t* ub; bf16_t* bb;
    __device__ __forceinline__ void operator()(const f32x4 (&acc)[2][2][4][2], const Unit& u, int wr, int wc, int fr, int fq) const {
        const int row0 = u.pm * BM + wr * 64 + fr;
        if (u.pn < 8) { const int col = u.pn * 128 + wc * 32 + 8 * fq;
#pragma unroll
            for (int ai = 0; ai < 2; ++ai)
#pragma unroll
                for (int m = 0; m < 4; ++m) *(u32x4*)(ub + (size_t)(row0 + ai * HALF + m * 16) * 1024 + col) = pack8(acc[ai][0][m][0] * acc[ai][1][m][0], acc[ai][0][m][1] * acc[ai][1][m][1]);
        } else { const int col = (u.pn - 8) * BM + wc * 32 + 8 * fq;
#pragma unroll
            for (int ai = 0; ai < 2; ++ai)
#pragma unroll
                for (int m = 0; m < 4; ++m)
#pragma unroll
                    for (int bj = 0; bj < 2; ++bj) *(u32x4*)(bb + (size_t)(row0 + ai * HALF + m * 16) * 1024 + col + bj * HALF) = pack8(acc[ai][bj][m][0], acc[ai][bj][m][1]);
        }
    }
};
constexpr int KVPOS = 8256;
struct EpiKV {
    static constexpr bool PERM = true, AFTER_DRAIN = false;
    bf16_t* Kb; bf16_t* Vb;
    __device__ __forceinline__ void operator()(const f32x4 (&acc)[2][2][4][2], const Unit& u, int wr, int wc, int fr, int fq) const {
        bf16_t* base = (u.pn < 4) ? Kb : Vb; const int h0 = (u.pn & 3) * 2, d = wc * 32 + 8 * fq;
        if (u.pm * BM < TOKROWS) {
#pragma unroll
            for (int ai = 0; ai < 2; ++ai)
#pragma unroll
                for (int m = 0; m < 4; ++m) { const int r = u.pm * BM + ai * HALF + wr * 64 + m * 16 + fr, b = r >> 13, t = r & 8191;
#pragma unroll
                    for (int bj = 0; bj < 2; ++bj) *(u32x4*)(base + ((size_t)(b * 8 + h0 + bj) * KVPOS + 16 + t) * 128 + d) = pack8(acc[ai][bj][m][0], acc[ai][bj][m][1]); }
        } else if (wr == 0) {
#pragma unroll
            for (int bj = 0; bj < 2; ++bj) { const u32x4 w = pack8(acc[0][bj][0][0], acc[0][bj][0][1]);
                *(u32x4*)(base + ((size_t)(0 * 8 + h0 + bj) * KVPOS + fr) * 128 + d) = w; *(u32x4*)(base + ((size_t)(1 * 8 + h0 + bj) * KVPOS + fr) * 128 + d) = w; }
        }
    }
};
struct EpiQ {
    static constexpr bool PERM = true, AFTER_DRAIN = false;
    bf16_t* Q;
    __device__ __forceinline__ void operator()(const f32x4 (&acc)[2][2][4][2], const Unit& u, int wr, int wc, int fr, int fq) const {
        const int h0 = u.pn * 2, d = wc * 32 + 8 * fq;
#pragma unroll
        for (int ai = 0; ai < 2; ++ai)
#pragma unroll
            for (int m = 0; m < 4; ++m) { const int r = u.pm * BM + ai * HALF + wr * 64 + m * 16 + fr, b = r >> 13, t = r & 8191;
#pragma unroll
                for (int bj = 0; bj < 2; ++bj) *(u32x4*)(Q + ((size_t)(b * 8 + h0 + bj) * 8192 + t) * 128 + d) = pack8(acc[ai][bj][m][0], acc[ai][bj][m][1]); }
    }
};

template <class Epi, class Sched, bool ALIGN_EPI = false, bool SP2 = false>
__device__ __forceinline__ void gemm_phase(PG8_LAS unsigned char* lds, const Gemm g, const Sched& S, const Epi& E) {
    int tid_ = threadIdx.x; asm volatile("" : "+v"(tid_));
    const int tid = tid_, wid = __builtin_amdgcn_readfirstlane(tid >> 6), lane = tid & 63, wr = wid >> 2, wc = wid & 3, fr = lane & 15, fq = lane >> 4;
    const int K = g.K, nt = K / BK;
    unsigned voffA[2], voffB[2];
#pragma unroll
    for (int i = 0; i < 2; ++i) { int R, C; stage_rc(tid * 16 + i * 8192, R, C); const int Rb = Epi::PERM ? ((R & ~31) + perm32(R & 31)) : R;
        voffA[i] = (unsigned)(R * K + C) * 2u; voffB[i] = (unsigned)(Rb * K + C) * 2u; }
    const size_t kstep = (size_t)(BK * 2);
    const size_t hstep = (size_t)HALF * K * 2;
    const size_t tstep = 2 * hstep;
    const unsigned ldsw = (unsigned)wid * 1024u;
    const int aoff = lds_byte(wr * 64 + fr, fq * 8), boff = lds_byte(wc * 32 + fr, fq * 8);
#define PG8_SA(b, h) (((b) * 2 + (h)) * HTB)
#define PG8_SB(b, h) ((4 + (b) * 2 + (h)) * HTB)
#define PG8_STAGE(bufoff, gbase, voff) do { _Pragma("unroll") for (int _i = 0; _i < 2; ++_i) \
        __builtin_amdgcn_global_load_lds((const unsigned*)((const char*)(gbase) + (voff)[_i]), (PG8_LAS unsigned*)(lds + (bufoff) + ldsw + _i * 8192), 16, 0, 0); } while (0)
#define PG8_LDA(dst, b, h) do { _Pragma("unroll") for (int m = 0; m < 4; ++m) _Pragma("unroll") for (int k = 0; k < 2; ++k) dst[m][k] = *(const PG8_LAS bf16x8*)(lds + PG8_SA(b, h) + aoff + m * 2048 + k * 1024); } while (0)
#define PG8_LDB(dst, b, h) do { _Pragma("unroll") for (int n = 0; n < 2; ++n) _Pragma("unroll") for (int k = 0; k < 2; ++k) dst[n][k] = *(const PG8_LAS bf16x8*)(lds + PG8_SB(b, h) + boff + n * 2048 + k * 1024); } while (0)
#define PG8_MMA(ai, bj, At, Bt) do { __builtin_amdgcn_s_setprio(1); _Pragma("unroll") for (int m = 0; m < 4; ++m) _Pragma("unroll") for (int n = 0; n < 2; ++n) _Pragma("unroll") for (int k = 0; k < 2; ++k) \
        acc[ai][bj][m][n] = __builtin_amdgcn_mfma_f32_16x16x32_bf16(Bt[n][k], At[m][k], acc[ai][bj][m][n], 0, 0, 0); __builtin_amdgcn_s_setprio(0); } while (0)
#define PG8_WAIT_V(n) asm volatile("s_waitcnt vmcnt(" #n ")" ::: "memory")
#define PG8_WAIT_L(n) asm volatile("s_waitcnt lgkmcnt(" #n ")" ::: "memory")
#define PG8_BAR __builtin_amdgcn_s_barrier()
#define PG8_SCHED __builtin_amdgcn_sched_barrier(0)
    Unit cur, nxt; int ui = 0;
    if (!S.next(0, cur)) return;
    f32x4 acc[2][2][4][2];
#pragma unroll
    for (int a = 0; a < 2; ++a)
#pragma unroll
        for (int b = 0; b < 2; ++b)
#pragma unroll
            for (int m = 0; m < 4; ++m)
#pragma unroll
                for (int n = 0; n < 2; ++n) acc[a][b][m][n] = (f32x4){0.f, 0.f, 0.f, 0.f};
    bf16x8 At[4][2], B0[2][2], B1[2][2];
    const char* cA = (const char*)g.A + (size_t)cur.pm * tstep; const char* cB = (const char*)g.Bt + (size_t)cur.pn * tstep;
    S.a_ready(cur);
    if constexpr (SP2) {
        PG8_STAGE(PG8_SB(0, 0), cB, voffB); PG8_STAGE(PG8_SB(0, 1), cB + hstep, voffB); PG8_STAGE(PG8_SA(0, 0), cA, voffA); PG8_STAGE(PG8_SA(0, 1), cA + hstep, voffA);
        if (wr == 1) PG8_BAR;
        PG8_WAIT_V(2); PG8_BAR;
        PG8_STAGE(PG8_SB(1, 0), cB + kstep, voffB); PG8_STAGE(PG8_SA(1, 0), cA + kstep, voffA); PG8_STAGE(PG8_SB(1, 1), cB + hstep + kstep, voffB);
        PG8_WAIT_V(6); PG8_BAR;
    } else {
        PG8_STAGE(PG8_SB(0, 0), cB, voffB); PG8_STAGE(PG8_SA(0, 0), cA, voffA); PG8_STAGE(PG8_SB(0, 1), cB + hstep, voffB); PG8_STAGE(PG8_SA(0, 1), cA + hstep, voffA);
        if (wr == 1) PG8_BAR;
        PG8_WAIT_V(4); PG8_BAR;
        PG8_STAGE(PG8_SB(1, 0), cB + kstep, voffB); PG8_STAGE(PG8_SA(1, 0), cA + kstep, voffA); PG8_STAGE(PG8_SB(1, 1), cB + hstep + kstep, voffB);
        PG8_WAIT_V(6); PG8_BAR;
    }
    for (;;) {
        const bool has_next = S.next(ui + 1, nxt);
        const char* nA = has_next ? (const char*)g.A + (size_t)nxt.pm * tstep : cA; const char* nB = has_next ? (const char*)g.Bt + (size_t)nxt.pn * tstep : cB;
        for (int t = 0; t < nt; t += 2) {
            const bool last = (t == nt - 2);
            const char* a1 = cA + (size_t)(t + 1) * kstep;
            const char* a2 = last ? nA : cA + (size_t)(t + 2) * kstep; const char* b2 = last ? nB : cB + (size_t)(t + 2) * kstep;
            const char* a3 = a2 + kstep; const char* b3 = b2 + kstep;
            if (last && has_next) S.a_ready(nxt);
            if constexpr (SP2) {
            PG8_LDB(B0, 0, 0); PG8_LDB(B1, 0, 1); PG8_SCHED; PG8_LDA(At, 0, 0); PG8_STAGE(PG8_SA(1, 1), a1 + hstep, voffA);
            PG8_WAIT_V(8); PG8_WAIT_L(0); PG8_BAR; PG8_MMA(0, 0, At, B0); PG8_MMA(0, 1, At, B1); PG8_BAR; PG8_SCHED;
            PG8_LDA(At, 0, 1); PG8_STAGE(PG8_SB(0, 0), b2, voffB); PG8_STAGE(PG8_SB(0, 1), b2 + hstep, voffB); PG8_STAGE(PG8_SA(0, 0), a2, voffA);
            PG8_WAIT_V(8); PG8_WAIT_L(0); PG8_BAR; PG8_MMA(1, 0, At, B0); PG8_MMA(1, 1, At, B1); PG8_BAR; PG8_SCHED;
            PG8_LDB(B0, 1, 0); PG8_LDB(B1, 1, 1); PG8_SCHED; PG8_LDA(At, 1, 0); PG8_STAGE(PG8_SA(0, 1), a2 + hstep, voffA);
            PG8_WAIT_V(8); PG8_WAIT_L(0); PG8_BAR; PG8_MMA(0, 0, At, B0); PG8_MMA(0, 1, At, B1); PG8_BAR; PG8_SCHED;
            PG8_LDA(At, 1, 1); PG8_STAGE(PG8_SB(1, 0), b3, voffB); PG8_STAGE(PG8_SB(1, 1), b3 + hstep, voffB); PG8_STAGE(PG8_SA(1, 0), a3, voffA);
            PG8_WAIT_V(8); PG8_WAIT_L(0); PG8_BAR; PG8_MMA(1, 0, At, B0); PG8_MMA(1, 1, At, B1); PG8_BAR; PG8_SCHED;
            } else {
            PG8_LDB(B0, 0, 0); PG8_SCHED; PG8_LDA(At, 0, 0); PG8_STAGE(PG8_SA(1, 1), a1 + hstep, voffA);
            PG8_WAIT_L(8); PG8_BAR; PG8_WAIT_L(0); PG8_MMA(0, 0, At, B0); PG8_BAR; PG8_SCHED;
            PG8_LDB(B1, 0, 1); PG8_STAGE(PG8_SB(0, 0), b2, voffB);
            PG8_BAR; PG8_WAIT_L(0); PG8_MMA(0, 1, At, B1); PG8_BAR;
            PG8_LDA(At, 0, 1); PG8_STAGE(PG8_SA(0, 0), a2, voffA);
            PG8_BAR; PG8_WAIT_L(0); PG8_MMA(1, 0, At, B0); PG8_BAR; PG8_SCHED;
            PG8_STAGE(PG8_SB(0, 1), b2 + hstep, voffB);
            PG8_WAIT_V(6); PG8_BAR; PG8_MMA(1, 1, At, B1); PG8_BAR;
            PG8_LDB(B0, 1, 0); PG8_SCHED; PG8_LDA(At, 1, 0); PG8_STAGE(PG8_SA(0, 1), a2 + hstep, voffA);
            PG8_WAIT_L(8); PG8_BAR; PG8_WAIT_L(0); PG8_MMA(0, 0, At, B0); PG8_BAR; PG8_SCHED;
            PG8_LDB(B1, 1, 1); PG8_STAGE(PG8_SB(1, 0), b3, voffB);
            PG8_BAR; PG8_WAIT_L(0); PG8_MMA(0, 1, At, B1); PG8_BAR;
            PG8_LDA(At, 1, 1); PG8_STAGE(PG8_SA(1, 0), a3, voffA);
            PG8_BAR; PG8_WAIT_L(0); PG8_MMA(1, 0, At, B0); PG8_BAR; PG8_SCHED;
            PG8_STAGE(PG8_SB(1, 1), b3 + hstep, voffB);
            PG8_WAIT_V(6); PG8_BAR; PG8_MMA(1, 1, At, B1); PG8_BAR;
            }
        }
        if constexpr (ALIGN_EPI) { if (wr == 0) PG8_BAR; }
        if constexpr (!Epi::AFTER_DRAIN) { E(acc, cur, wr, wc, fr, fq); S.done(cur); }
        if (!has_next) break;
#pragma unroll
        for (int a = 0; a < 2; ++a)
#pragma unroll
            for (int b = 0; b < 2; ++b)
#pragma unroll
                for (int m = 0; m < 4; ++m)
#pragma unroll
                    for (int n = 0; n < 2; ++n) acc[a][b][m][n] = (f32x4){0.f, 0.f, 0.f, 0.f};
        cur = nxt; cA = nA; cB = nB; ++ui;
        if constexpr (ALIGN_EPI) { if (wr == 1) PG8_BAR; }
    }
    PG8_WAIT_V(0);
    if constexpr (!ALIGN_EPI) { if (wr == 0) PG8_BAR; }
    PG8_BAR;
    if constexpr (Epi::AFTER_DRAIN) { E.fused(acc, cur, wr, wc, fr, fq, lds, wid, lane); S.done(cur); }
#undef PG8_SA
#undef PG8_SB
#undef PG8_STAGE
#undef PG8_LDA
#undef PG8_LDB
#undef PG8_MMA
#undef PG8_WAIT_V
#undef PG8_WAIT_L
#undef PG8_BAR
#undef PG8_SCHED
}
}
namespace att {
#define ALAS __attribute__((address_space(3)))
constexpr int D = 128, OSTR = 1024;
constexpr float THR = 8.f;
constexpr bool WSKIP = false;
constexpr float SCALE = 0.08838834764831845f;
constexpr int NW = 8, QBLK = 32, KVBLK = 64, QB = NW * QBLK;
constexpr int SHM_V = KVBLK * D * 2, SHM_K = KVBLK * D * 2;
constexpr int CB_FLOATS = 8256;
constexpr int LDS_BYTES = 2 * SHM_V + 2 * SHM_K + NW * 64 * 4 + CB_FLOATS * 4;
using bf16 = __hip_bfloat16;
typedef short bf16x8 __attribute__((ext_vector_type(8)));
typedef short s16x4 __attribute__((ext_vector_type(4)));
typedef float f32x16 __attribute__((ext_vector_type(16)));
typedef float f32x4 __attribute__((ext_vector_type(4)));
typedef unsigned u32x4 __attribute__((ext_vector_type(4)));
template <class A, class Bt> struct same_t { static constexpr bool v = false; };
template <class A> struct same_t<A, A> { static constexpr bool v = true; };
#define KSWZ(row, colB) ((row) * 256 + ((colB) ^ (((row) & 7) << 4)))
#define SBAR() __builtin_amdgcn_sched_barrier(0)
__device__ __forceinline__ int v_st(int k, int c) { const int kk = (k & ~0xC) | ((k & 4) << 1) | ((k & 8) >> 1); return ((kk >> 3) * 4 + (c >> 5)) * 512 + ((kk & 7) * 32 + (c & 31)) * 2; }
__device__ __forceinline__ int v_rd_base(int lane) { return ((lane & 3) << 3) | (((lane >> 2) & 3) << 6) | (((lane >> 4) & 1) << 5) | (((lane >> 5) & 1) << 8); }
constexpr int v_rd_off(int d0, int ks, int half) { return d0 * 512 + ks * 4096 + half * 2048; }
__device__ __forceinline__ int crow(int r, int hi) { return (r & 3) + 8 * (r >> 2) + 4 * hi; }
__device__ __forceinline__ unsigned cvtpk(float lo, float hi) {
    unsigned r; asm volatile("v_cvt_pk_bf16_f32 %0, %1, %2" : "=v"(r) : "v"(lo), "v"(hi)); return r;
}
__device__ __forceinline__ bf16x8 pack8(f32x4 a, f32x4 b) {
    u32x4 w = {cvtpk(a[0], a[1]), cvtpk(a[2], a[3]), cvtpk(b[0], b[1]), cvtpk(b[2], b[3])};
    return *reinterpret_cast<bf16x8*>(&w);
}
template <class T> __device__ __forceinline__ bf16x8 load8(const T* p) {
    if constexpr (same_t<T, float>::v) { return pack8(*(const f32x4*)p, *(const f32x4*)(p + 4)); }
    else { return *reinterpret_cast<const bf16x8*>(p); }
}
__device__ __forceinline__ void mask_tile(f32x16& p0, f32x16& p1, int dq, unsigned W) {
    const float NEG = -__builtin_inff();
#pragma unroll
    for (int r = 0; r < 16; ++r) {
        const int c = (r & 3) + 8 * (r >> 2);
        if ((unsigned)(dq - c) >= W) p0[r] = NEG;
        if ((unsigned)(dq - c - 32) >= W) p1[r] = NEG;
    }
}
__device__ __forceinline__ void partialSM(f32x16& p0, f32x16& p1, float& m_reg, float& mn, float& alpha) {
    float pmax = p0[0]; for (int r = 1; r < 16; ++r) pmax = fmaxf(pmax, p0[r]); for (int r = 0; r < 16; ++r) pmax = fmaxf(pmax, p1[r]);
    { auto rr = __builtin_amdgcn_permlane32_swap(__float_as_uint(pmax), __float_as_uint(pmax), false, false);
      pmax = fmaxf(__uint_as_float(rr[0]), __uint_as_float(rr[1])); }
    constexpr float C2 = 1.4426950408889634f * SCALE;
    if (__builtin_expect(__all((pmax - m_reg) * SCALE <= THR), 1)) { mn = m_reg; alpha = 1.f; }
    else { mn = fmaxf(m_reg, pmax); alpha = __builtin_amdgcn_exp2f((m_reg - mn) * C2); m_reg = mn; }
    const float mnL = -mn * C2;
    for (int r = 0; r < 16; ++r) p0[r] = fmaf(p0[r], C2, mnL); for (int r = 0; r < 16; ++r) p1[r] = fmaf(p1[r], C2, mnL);
    for (int r = 0; r < 16; ++r) p0[r] = __builtin_amdgcn_exp2f(p0[r]);
}
__device__ __forceinline__ void finishSM(f32x16& p0, f32x16& p1, float alpha, float& l_reg, bf16x8& pa0, bf16x8& pa1, bf16x8& pa2, bf16x8& pa3) {
    for (int r = 0; r < 16; ++r) p1[r] = __builtin_amdgcn_exp2f(p1[r]);
    float ps = 0; for (int r = 0; r < 16; ++r) ps += p0[r]; for (int r = 0; r < 16; ++r) ps += p1[r];
    { auto rr = __builtin_amdgcn_permlane32_swap(__float_as_uint(ps), __float_as_uint(ps), false, false);
      ps = __uint_as_float(rr[0]) + __uint_as_float(rr[1]); }
    l_reg = l_reg * alpha + ps;
#define PK4(P, B_, OUT) do { unsigned a0 = cvtpk(P[B_+0], P[B_+1]), a1 = cvtpk(P[B_+2], P[B_+3]);                          \
        unsigned b0 = cvtpk(P[B_+4], P[B_+5]), b1 = cvtpk(P[B_+6], P[B_+7]);                                             \
        auto r0 = __builtin_amdgcn_permlane32_swap(a0, b0, false, false); auto r1 = __builtin_amdgcn_permlane32_swap(a1, b1, false, false); \
        u32x4 w = {r0[0], r1[0], r0[1], r1[1]}; OUT = *reinterpret_cast<bf16x8*>(&w); } while (0)
    PK4(p0, 0, pa0); PK4(p0, 8, pa1); PK4(p1, 0, pa2); PK4(p1, 8, pa3);
#undef PK4
}
template <int KB, bool SK>
__device__ __forceinline__ void qkt(f32x16& p0, f32x16& p1, const char* K_lds, int r32, int hi, const bf16x8* qr, bool act, const ALAS float* cbt) {
    if (SK && !act) { const float NEG = -__builtin_inff();
#pragma unroll
        for (int r = 0; r < 16; ++r) { p0[r] = NEG; p1[r] = NEG; } return; }
#pragma unroll
    for (int g = 0; g < 4; ++g) { const f32x4 ba = *(const ALAS f32x4*)(cbt + 8 * g), bb = *(const ALAS f32x4*)(cbt + 32 + 8 * g);
        p0[4 * g] = ba[0]; p0[4 * g + 1] = ba[1]; p0[4 * g + 2] = ba[2]; p0[4 * g + 3] = ba[3]; p1[4 * g] = bb[0]; p1[4 * g + 1] = bb[1]; p1[4 * g + 2] = bb[2]; p1[4 * g + 3] = bb[3]; }
    const char* kb[4];
#pragma unroll
    for (int dd = 0; dd < 4; ++dd) kb[dd] = K_lds + KB * SHM_K + KSWZ(r32, (dd * 16 + hi * 8) * 2);
#pragma unroll
    for (int d0 = 0; d0 < 8; ++d0) { const char* a = kb[d0 & 3] + (d0 >> 2) * 128;
        bf16x8 b0 = *reinterpret_cast<const bf16x8*>(a);
        bf16x8 b1 = *reinterpret_cast<const bf16x8*>(a + 32 * 256);
        p0 = __builtin_amdgcn_mfma_f32_32x32x16_bf16(b0, qr[d0], p0, 0, 0, 0);
        p1 = __builtin_amdgcn_mfma_f32_32x32x16_bf16(b1, qr[d0], p1, 0, 0, 0); }
}
template <int VB, bool SK>
__device__ __forceinline__ void pv_tile(f32x16* o, int vb0, bf16x8 pa0, bf16x8 pa1, bf16x8 pa2, bf16x8 pa3, bool act) {
    if (SK && !act) return;
#define TRRD(dst, off) asm volatile("ds_read_b64_tr_b16 %0, %1 offset:%2" : "=&v"(dst) : "v"(vb0), "i"(off) : "memory")
#define PV_D0(d0) do { s16x4 l0, l1, l2, l3, h0, h1, h2, h3; constexpr int b_ = VB * SHM_V + v_rd_off(d0, 0, 0);     \
        TRRD(l0, b_); TRRD(h0, b_ + 2048); TRRD(l1, b_ + 4096); TRRD(h1, b_ + 6144); TRRD(l2, b_ + 8192); TRRD(h2, b_ + 10240); TRRD(l3, b_ + 12288); TRRD(h3, b_ + 14336); \
        asm volatile("s_waitcnt lgkmcnt(0)" ::: "memory"); SBAR();                 \
        o[d0] = __builtin_amdgcn_mfma_f32_32x32x16_bf16(pa0, (bf16x8){l0[0], l0[1], l0[2], l0[3], h0[0], h0[1], h0[2], h0[3]}, o[d0], 0, 0, 0);   \
        o[d0] = __builtin_amdgcn_mfma_f32_32x32x16_bf16(pa1, (bf16x8){l1[0], l1[1], l1[2], l1[3], h1[0], h1[1], h1[2], h1[3]}, o[d0], 0, 0, 0);   \
        o[d0] = __builtin_amdgcn_mfma_f32_32x32x16_bf16(pa2, (bf16x8){l2[0], l2[1], l2[2], l2[3], h2[0], h2[1], h2[2], h2[3]}, o[d0], 0, 0, 0);   \
        o[d0] = __builtin_amdgcn_mfma_f32_32x32x16_bf16(pa3, (bf16x8){l3[0], l3[1], l3[2], l3[3], h3[0], h3[1], h3[2], h3[3]}, o[d0], 0, 0, 0); } while (0)
    PV_D0(0); PV_D0(1); PV_D0(2); PV_D0(3);
#undef PV_D0
#undef TRRD
}

template <class TIn, class TOut> struct BlockRef { const TIn* Q; const TIn* K; const TIn* V; TOut* O; const float* CB; int P0; };
template <class TIn> struct Seam {
    bf16x8 qr[8];
    bf16x8 st_v0, st_v1, st_k0, st_k1; f32x4 sf0, sf1, sf2, sf3;
    f32x4 tq[16];
};
__device__ __forceinline__ int swa_jlo(int P0, int W) { const int lowk = P0 - W + 1; return lowk > 0 ? lowk / KVBLK : 0; }
#define ROW(p, k0, rr) ((p) + (size_t)((k0) + (rr)) * D + sc)
#define VMW() asm volatile("s_waitcnt vmcnt(0)" ::: "memory")
#define VMWN(n) asm volatile("s_waitcnt vmcnt(%0)" :: "i"(n) : "memory")
#define SLOAD_H(Kp, Vp, k0) do { S.st_v0 = load8<TIn>(ROW(Vp, k0, sr)); S.st_v1 = load8<TIn>(ROW(Vp, k0, 32 + sr));              \
                         S.st_k0 = load8<TIn>(ROW(Kp, k0, sr)); S.st_k1 = load8<TIn>(ROW(Kp, k0, 32 + sr)); } while (0)
#define SWRITE_HK(bf) do { *(bf16x8*)(K_lds + (bf) * SHM_K + kws) = S.st_k0; *(bf16x8*)(K_lds + (bf) * SHM_K + kws + 32 * 256) = S.st_k1; } while (0)
#define SWRITE_HV(bf) do { *(bf16x8*)(V_lds + (bf) * SHM_V + vst0) = S.st_v0; *(bf16x8*)(V_lds + (bf) * SHM_V + vst1) = S.st_v1; } while (0)
#define SWRITE_H(bf) do { SWRITE_HV(bf); SWRITE_HK(bf); } while (0)
#define SLOAD_F(p, k0) do { S.sf0 = *(const f32x4*)ROW(p, k0, sr); S.sf1 = *(const f32x4*)(ROW(p, k0, sr) + 4);                \
                            S.sf2 = *(const f32x4*)ROW(p, k0, 32 + sr); S.sf3 = *(const f32x4*)(ROW(p, k0, 32 + sr) + 4); } while (0)
#define SWRITE_KF(bf) do { *(bf16x8*)(K_lds + (bf) * SHM_K + kws) = pack8(S.sf0, S.sf1); *(bf16x8*)(K_lds + (bf) * SHM_K + kws + 32 * 256) = pack8(S.sf2, S.sf3); } while (0)
#define SWRITE_VF(bf) do { *(bf16x8*)(V_lds + (bf) * SHM_V + vst0) = pack8(S.sf0, S.sf1); *(bf16x8*)(V_lds + (bf) * SHM_V + vst1) = pack8(S.sf2, S.sf3); } while (0)
template <class TIn, class TOut>
__device__ __forceinline__ void causal_swa_prime(const BlockRef<TIn, TOut>& cur, int W, char* lds, Seam<TIn>& S) {
    constexpr bool F32 = same_t<TIn, float>::v;
    int tid_ = threadIdx.x; asm volatile("" : "+v"(tid_));
    const int tid = tid_, wid = __builtin_amdgcn_readfirstlane(tid >> 6), lane = tid & 63, r32 = lane & 31, hi = lane >> 5;
    const int sr = tid >> 4, sc = (tid & 15) * 8, kws = KSWZ(sr, sc * 2); char* K_lds = lds + 2 * SHM_V;
    const int kb0 = swa_jlo(cur.P0, W) * KVBLK;
    for (int d0 = 0; d0 < 8; ++d0) S.qr[d0] = load8<TIn>(cur.Q + (size_t)(wid * QBLK + r32) * D + d0 * 16 + hi * 8);
    if constexpr (F32) { SLOAD_F((const float*)cur.K, kb0); VMW(); SWRITE_KF(0); SBAR(); SLOAD_F((const float*)cur.V, kb0); }
    else { SLOAD_H(cur.K, cur.V, kb0); VMW(); SWRITE_HK(0); }
    __syncthreads();
}
template <class TIn, class TOut>
__device__ __forceinline__ void causal_swa_block(const BlockRef<TIn, TOut>& cur, const BlockRef<TIn, TOut>& nxt, int skv, int W, char* lds, Seam<TIn>& S) {
    constexpr bool F32 = same_t<TIn, float>::v;
    int tid_ = threadIdx.x; asm volatile("" : "+v"(tid_));
    const int tid = tid_, wid = __builtin_amdgcn_readfirstlane(tid >> 6), lane = tid & 63, r32 = lane & 31, hi = lane >> 5;
    const int j_lo = swa_jlo(cur.P0, W);
    int j_hi = (cur.P0 + QB - 1) / KVBLK + 1; if (j_hi > skv / KVBLK) j_hi = skv / KVBLK;
    const int NT = j_hi - j_lo;
    const int kbn = swa_jlo(nxt.P0, W) * KVBLK;
    const int qlo = cur.P0 + wid * QBLK, qm = qlo + r32 - 4 * hi;
    char* V_lds = lds; char* K_lds = lds + 2 * SHM_V;
    float* ws = (float*)(lds + 2 * SHM_V + 2 * SHM_K) + wid * 64; float* li_l = ws, * al_l = ws + 32;
    float m_reg = -1e30f, l_reg = 0; f32x16 o[4] = {};
    const ALAS float* cbl = (const ALAS float*)(lds + 2 * SHM_V + 2 * SHM_K + NW * 64 * 4);
    { const int nk4 = j_hi * (KVBLK / 4); for (int i = tid; i < nk4; i += 64 * NW) ((ALAS f32x4*)cbl)[i] = ((const f32x4*)cur.CB)[i]; __syncthreads(); }
    const int sr = tid >> 4, sc = (tid & 15) * 8, vst0 = v_st(sr, sc), vst1 = v_st(32 + sr, sc), kws = KSWZ(sr, sc * 2);
    const int vb0 = (int)(uintptr_t)V_lds + v_rd_base(lane);
    const TIn* Kh = cur.K; const TIn* Vh = cur.V;
#define RESC(a) do { if (__any((a) < 1.f)) { if (hi == 0) al_l[r32] = (a); asm volatile("s_waitcnt lgkmcnt(0)" ::: "memory");              \
                     for (int d_ = 0; d_ < 4; ++d_) for (int r = 0; r < 16; ++r) o[d_][r] *= al_l[crow(r, hi)]; } } while (0)
#define KBASE(t) ((j_lo + (t)) * KVBLK)
#define CBT(t) (cbl + KBASE(t) + 4 * hi)
#define ACT(t) (KBASE(t) <= qlo + QBLK - 1 && KBASE(t) + KVBLK - 1 >= qlo - W + 1)
#define MASKT(P0_, P1_, t) do { const int kb_ = KBASE(t); if ((!SK || ACT(t)) && (kb_ + KVBLK - 1 > qlo || kb_ <= qlo + QBLK - 1 - W)) mask_tile(P0_, P1_, qm - kb_, (unsigned)W); } while (0)
    constexpr int NQL = F32 ? 16 : 8;
    constexpr bool SK = WSKIP && !F32;
#define SEAM_K0() do { VMWN(NQL); if constexpr (F32) { SWRITE_KF(0); SBAR(); SLOAD_F((const float*)nxt.V, kbn); } else { SWRITE_HK(0); } SBAR(); } while (0)
    f32x16 pA0, pA1, pB0, pB1; float mnA, mnB, alA, alB; bf16x8 pa0, pa1, pa2, pa3;
    if constexpr (F32) { VMW(); SWRITE_VF(0); SBAR(); } else { SWRITE_HV(0); SBAR(); }
    if (NT > 1) { if constexpr (F32) SLOAD_F((const float*)Kh, KBASE(1)); else SLOAD_H(Kh, Vh, KBASE(1)); }
    SBAR(); qkt<0, SK>(pA0, pA1, K_lds, r32, hi, S.qr, ACT(0), CBT(0));
    if constexpr (F32) { if (NT > 1) { VMW(); SWRITE_KF(1); SBAR(); SLOAD_F((const float*)Vh, KBASE(1)); } }
    MASKT(pA0, pA1, 0); partialSM(pA0, pA1, m_reg, mnA, alA);
    if (NT > 1) { VMW(); if constexpr (F32) { SWRITE_VF(1); SBAR(); if (NT > 2) SLOAD_F((const float*)Kh, KBASE(2)); } else SWRITE_H(1); }
    __syncthreads();
#define HALF_STEP(PX0, PX1, mnX, alX, PY0, PY1, alY, t, KB, VB, SB) do {                                                      \
        SBAR(); qkt<KB, SK>(PX0, PX1, K_lds, r32, hi, S.qr, ACT(t), CBT(t));                                             \
        finishSM(PY0, PY1, alY, l_reg, pa0, pa1, pa2, pa3); SBAR();                                                           \
        if ((t) + 1 < NT) { if constexpr (F32) { VMW(); SWRITE_KF(SB); SBAR(); SLOAD_F((const float*)Vh, KBASE((t) + 1)); }  \
                            else { SLOAD_H(Kh, Vh, KBASE((t) + 1)); } SBAR(); }                                               \
        pv_tile<VB, SK>(o, vb0, pa0, pa1, pa2, pa3, ACT((t) - 1)); MASKT(PX0, PX1, (t)); partialSM(PX0, PX1, m_reg, mnX, alX);                                        \
        __syncthreads();                                                                                                      \
        if ((t) + 1 < NT) { VMW(); if constexpr (F32) { SWRITE_VF(SB); SBAR(); if ((t) + 2 < NT) SLOAD_F((const float*)Kh, KBASE((t) + 2)); } \
                            else { SWRITE_H(SB); } }                                                                          \
        RESC(alX); __syncthreads(); } while (0)
    for (int t = 1; t + 1 < NT; t += 2) {
        HALF_STEP(pB0, pB1, mnB, alB, pA0, pA1, alA, t, 1, 0, 0);
        HALF_STEP(pA0, pA1, mnA, alA, pB0, pB1, alB, t + 1, 0, 1, 1);
    }
    const bool even = (NT & 1) == 0;
    if (even) { SBAR(); qkt<1, SK>(pB0, pB1, K_lds, r32, hi, S.qr, ACT(NT - 1), CBT(NT - 1)); SBAR(); }
#define QROW(e) (nxt.Q + (size_t)(wid * QBLK + r32) * D + ((e) >> 1) * 16 + hi * 8 + ((e) & 1) * 4)
    if constexpr (F32) { SLOAD_F((const float*)nxt.K, kbn); SBAR();
#pragma unroll
        for (int e = 0; e < 8; ++e) S.tq[e] = *(const f32x4*)QROW(e); }
    else { SLOAD_H(nxt.K, nxt.V, kbn); SBAR();
#pragma unroll
        for (int d0 = 0; d0 < 8; ++d0) S.qr[d0] = load8<TIn>(nxt.Q + (size_t)(wid * QBLK + r32) * D + d0 * 16 + hi * 8); }
    SBAR();
    finishSM(pA0, pA1, alA, l_reg, pa0, pa1, pa2, pa3); SBAR();
    if constexpr (F32) {
#pragma unroll
        for (int e = 8; e < 16; ++e) S.tq[e] = *(const f32x4*)QROW(e); SBAR(); }
#undef QROW
    pv_tile<0, SK>(o, vb0, pa0, pa1, pa2, pa3, ACT(even ? NT - 2 : NT - 1));
    if (even) { MASKT(pB0, pB1, NT - 1); partialSM(pB0, pB1, m_reg, mnB, alB); __syncthreads(); RESC(alB);
        finishSM(pB0, pB1, alB, l_reg, pa0, pa1, pa2, pa3); SBAR(); pv_tile<1, SK>(o, vb0, pa0, pa1, pa2, pa3, ACT(NT - 1)); }
    SBAR(); SEAM_K0();
    if (hi == 0) li_l[r32] = l_reg; asm volatile("s_waitcnt lgkmcnt(0)" ::: "memory");
    float rli[16];
#pragma unroll
    for (int r = 0; r < 16; ++r) rli[r] = __builtin_amdgcn_rcpf(li_l[crow(r, hi)]);
    TOut* Ow = cur.O + (size_t)(wid * QBLK) * OSTR;
#pragma unroll
    for (int r = 0; r < 16; ++r) { const int orow = crow(r, hi);
#pragma unroll
        for (int d0 = 0; d0 < 4; ++d0) { const float v = o[d0][r] * rli[r];
            if constexpr (same_t<TOut, float>::v) { Ow[(size_t)orow * OSTR + d0 * 32 + r32] = v; }
            else { const float vn = __shfl_xor(v, 1);
                   if ((r32 & 1) == 0) *(unsigned*)(Ow + (size_t)orow * OSTR + d0 * 32 + r32) = cvtpk(v, vn); } } }
    if constexpr (F32) {
#pragma unroll
        for (int d0 = 0; d0 < 8; ++d0) S.qr[d0] = pack8(S.tq[2 * d0], S.tq[2 * d0 + 1]); }
    __syncthreads();
#undef RESC
#undef KBASE
#undef CBT
#undef ACT
#undef MASKT
#undef SEAM_K0
#undef HALF_STEP
}
#undef ROW
#undef VMW
#undef VMWN
#undef SLOAD_H
#undef SWRITE_HK
#undef SWRITE_HV
#undef SWRITE_H
#undef SLOAD_F
#undef SWRITE_KF
#undef SWRITE_VF

#undef KSWZ
#undef SBAR
}

#define LAS __attribute__((address_space(3)))
typedef unsigned short bf16;
typedef float f32x4 __attribute__((ext_vector_type(4)));
typedef unsigned u32x4 __attribute__((ext_vector_type(4)));
typedef unsigned u32x2 __attribute__((ext_vector_type(2)));
constexpr int NWAVES = 8, NTHR = 512;
constexpr int DM = 1024, FF = 2816, TOK = 16384, MT = 16640, NMETA = 16, SEQ = 8192, NH = 8, KVPOS = 8256;
constexpr float LN_EPS = 1e-5f;
constexpr size_t MiB = 1u << 20;
constexpr size_t UPSZ = (size_t)2 * FF * DM, DNSZ = (size_t)DM * FF, SQ = (size_t)DM * DM;
constexpr size_t W_UP10 = 0, W_DN10 = W_UP10 + UPSZ, W_UP20 = W_DN10 + DNSZ, W_DN20 = W_UP20 + UPSZ, W_CIN = W_DN20 + DNSZ, W_COUT = W_CIN + 3 * SQ, W_KV = W_COUT + SQ,
                 W_UP11 = W_KV + 2 * SQ, W_DN11 = W_UP11 + UPSZ, W_UP21 = W_DN11 + DNSZ, W_DN21 = W_UP21 + UPSZ, W_Q = W_DN21 + DNSZ, W_O = W_Q + SQ, W_END = W_O + SQ;
constexpr size_t WS_W = 1 * MiB, WS_HB = 84 * MiB, WS_BIG = 117 * MiB, WS_V = 207 * MiB, WS_XM = 240 * MiB, WS_FLOG = 241 * MiB, WS_CB = 242 * MiB, WS_END = 243 * MiB;
static_assert(WS_W + W_END * 2 <= WS_HB && WS_HB + (size_t)MT * DM * 2 <= WS_BIG && WS_BIG + (size_t)MT * FF * 2 <= WS_V && WS_V + (size_t)2 * NH * KVPOS * 128 * 2 <= WS_XM, "ws map");
static_assert((size_t)2 * NH * KVPOS * 128 * 2 <= W_CIN * 2, "K overlay fits in the dead layer-0 FFN weights");
static_assert((size_t)(MT + NMETA) * NH * 4 <= MiB && (size_t)2 * NH * KVPOS * 4 <= MiB && (size_t)256 * DM * 4 <= MiB, "small buffers");
constexpr int LDS_PHASE = 131072, LDS_TOTAL = LDS_PHASE + 256;
static_assert(att::LDS_BYTES <= LDS_PHASE && pg8::STAGE_BYTES <= LDS_PHASE, "LDS");

struct Args { const float* in[17]; float* out; unsigned char* ws; };

__device__ __forceinline__ unsigned pk2(float lo, float hi) { return pg8::cvt_pk_bf16(lo, hi); }
__device__ __forceinline__ float wave_sum(float v) {
#pragma unroll
    for (int o = 1; o < 64; o <<= 1) v += __shfl_xor(v, o);
    return v;
}
__device__ __forceinline__ void tr_item(const float* W, int ldw, int K, int k0, int n0, bf16* WTrow0, LAS float* scr, int lane) {
#pragma unroll 8
    for (int i = 0; i < 32; ++i) { const int kk = 2 * i + (lane >> 5); scr[kk * 33 + (lane & 31)] = W[(size_t)(k0 + kk) * ldw + n0 + (lane & 31)]; }
    asm volatile("s_waitcnt lgkmcnt(0)" ::: "memory");
    const int c = lane & 7;
#pragma unroll
    for (int j = 0; j < 4; ++j) { const int n = (lane >> 3) + 8 * j; const LAS float* s = scr + (8 * c) * 33 + n;
        u32x4 o; o.x = pk2(s[0 * 33], s[1 * 33]); o.y = pk2(s[2 * 33], s[3 * 33]); o.z = pk2(s[4 * 33], s[5 * 33]); o.w = pk2(s[6 * 33], s[7 * 33]);
        *(u32x4*)(WTrow0 + (size_t)n * K + k0 + 8 * c) = o; }
    asm volatile("s_waitcnt lgkmcnt(0)" ::: "memory");
}
__device__ __forceinline__ int drow(int kind, int n0) {
    if (kind == 0) return n0;
    if (kind == 1) return (n0 >> 7) * 256 + (n0 & 127);
    if (kind == 2) return (n0 >> 7) * 256 + 128 + (n0 & 127);
    if (n0 < 1024) return 2048 + n0;
    if (n0 < 2048) { const int j = n0 - 1024; return (j >> 7) * 256 + (j & 127); }
    { const int j = n0 - 2048; return (j >> 7) * 256 + 128 + (j & 127); }
}
#define TR_TRY(Wp, ldw_, K_, N_, dst_, kind_) { const int cnt_ = ((K_) / 64) * ((N_) / 32); if (r < cnt_) { const int nblk_ = (N_) / 32, kb_ = r / nblk_, n0_ = (r % nblk_) * 32; \
        tr_item((Wp), (ldw_), (K_), kb_ * 64, n0_, (dst_) + (size_t)drow((kind_), n0_) * (K_), scr, lane); continue; } r -= cnt_; }
__device__ __forceinline__ void p0_prologue(const Args& a, LAS unsigned char* lds, int vcu, int G) {
    int tid_ = threadIdx.x; asm volatile("" : "+v"(tid_)); const int lane = tid_ & 63, wave = __builtin_amdgcn_readfirstlane(tid_ >> 6); (void)lane; (void)wave;
    const int gw = vcu * NWAVES + wave, NGW = G * NWAVES, gtid = blockIdx.x * NTHR + tid_, NGT = G * NTHR;
    bf16* WT = (bf16*)(a.ws + WS_W);
    LAS float* scr = (LAS float*)(lds + wave * 16384);
    constexpr int I_UP = (DM / 64) * (FF / 32), I_DN = (FF / 64) * (DM / 32), I_SQ = (DM / 64) * (DM / 32);
    constexpr int NITEMS = 8 * I_UP + 4 * I_DN + 3 * I_SQ + 2 * I_SQ + 3 * I_SQ;
    for (int it = gw; it < NITEMS; it += NGW) {
        int r = it;
        TR_TRY(a.in[2], FF, DM, FF, WT + W_UP10, 1) TR_TRY(a.in[3], FF, DM, FF, WT + W_UP10, 2) TR_TRY(a.in[4], DM, FF, DM, WT + W_DN10, 0)
        TR_TRY(a.in[5], FF, DM, FF, WT + W_UP20, 1) TR_TRY(a.in[6], FF, DM, FF, WT + W_UP20, 2) TR_TRY(a.in[7], DM, FF, DM, WT + W_DN20, 0)
        TR_TRY(a.in[10], 3 * DM, DM, 3 * DM, WT + W_CIN, 3) TR_TRY(a.in[12], DM, DM, DM, WT + W_COUT, 0) TR_TRY(a.in[13], 2 * DM + NH, DM, 2 * DM, WT + W_KV, 0)
        TR_TRY(a.in[2] + (size_t)DM * FF, FF, DM, FF, WT + W_UP11, 1) TR_TRY(a.in[3] + (size_t)DM * FF, FF, DM, FF, WT + W_UP11, 2) TR_TRY(a.in[4] + (size_t)DM * FF, DM, FF, DM, WT + W_DN11, 0)
        TR_TRY(a.in[5] + (size_t)DM * FF, FF, DM, FF, WT + W_UP21, 1) TR_TRY(a.in[6] + (size_t)DM * FF, FF, DM, FF, WT + W_UP21, 2) TR_TRY(a.in[7] + (size_t)DM * FF, DM, FF, DM, WT + W_DN21, 0)
        TR_TRY(a.in[15], DM, DM, DM, WT + W_Q, 0) TR_TRY(a.in[16], DM, DM, DM, WT + W_O, 0)
    }
    bf16* hb = (bf16*)(a.ws + WS_HB); const float* x = a.in[0];
    for (int idx = gtid; idx < TOK * 128; idx += NGT) { const f32x4 v0 = *(const f32x4*)(x + (size_t)idx * 8), v1 = *(const f32x4*)(x + (size_t)idx * 8 + 4);
        *(u32x4*)(hb + (size_t)idx * 8) = pg8::pack8(v0, v1); }
    float* Xm = (float*)(a.ws + WS_XM); const float* meta = a.in[1];
    for (int idx = gtid; idx < 256 * 128; idx += NGT) { const int row = idx >> 7; f32x4 v0 = {0.f, 0.f, 0.f, 0.f}, v1 = v0;
        if (row < NMETA) { v0 = *(const f32x4*)(meta + (size_t)idx * 8); v1 = *(const f32x4*)(meta + (size_t)idx * 8 + 4); }
        *(f32x4*)(Xm + (size_t)idx * 8) = v0; *(f32x4*)(Xm + (size_t)idx * 8 + 4) = v1; *(u32x4*)(hb + (size_t)TOK * DM + (size_t)idx * 8) = pg8::pack8(v0, v1); }
    bf16* Vb = (bf16*)(a.ws + WS_V);
    for (int idx = gtid; idx < 16 * 48 * 16; idx += NGT) { const int bh = idx / (48 * 16), rem = idx % (48 * 16);
        *(u32x4*)(Vb + ((size_t)bh * KVPOS + 8208) * 128 + (size_t)rem * 8) = (u32x4){0u, 0u, 0u, 0u}; }
}
template <bool HB, bool FLOG>
__device__ __forceinline__ void ln_phase(const Args& a, LAS unsigned char* lds, int nrows, const float* gain, const float* beta, int vcu, int G) {
    int tid_ = threadIdx.x; asm volatile("" : "+v"(tid_)); const int lane = tid_ & 63, wave = __builtin_amdgcn_readfirstlane(tid_ >> 6); (void)lane; (void)wave;
    const int gw = vcu * NWAVES + wave, NGW = G * NWAVES;
    float* Xt = a.out; float* Xm = (float*)(a.ws + WS_XM); bf16* hb = (bf16*)(a.ws + WS_HB); float* flog = (float*)(a.ws + WS_FLOG);
    LAS float* wfl = (LAS float*)lds;
    if (FLOG) { const float* kvw = a.in[13];
        for (int k = tid_; k < DM; k += NTHR) { const f32x4 w0 = *(const f32x4*)(kvw + (size_t)k * (2 * DM + NH) + 2 * DM), w1 = *(const f32x4*)(kvw + (size_t)k * (2 * DM + NH) + 2 * DM + 4);
            wfl[0 * DM + k] = w0[0]; wfl[1 * DM + k] = w0[1]; wfl[2 * DM + k] = w0[2]; wfl[3 * DM + k] = w0[3]; wfl[4 * DM + k] = w1[0]; wfl[5 * DM + k] = w1[1]; wfl[6 * DM + k] = w1[2]; wfl[7 * DM + k] = w1[3]; }
        __syncthreads(); }
    f32x4 g[4], bt[4];
#pragma unroll
    for (int j = 0; j < 4; ++j) { g[j] = *(const f32x4*)(gain + 4 * lane + 256 * j); bt[j] = *(const f32x4*)(beta + 4 * lane + 256 * j); }
    for (int row = gw; row < nrows; row += NGW) {
        float* xr = (row < TOK) ? Xt + (size_t)row * DM : Xm + (size_t)(row - TOK) * DM;
        f32x4 v[4]; float s = 0.f;
#pragma unroll
        for (int j = 0; j < 4; ++j) { v[j] = *(const f32x4*)(xr + 4 * lane + 256 * j); s += (v[j][0] + v[j][1]) + (v[j][2] + v[j][3]); }
        const float mean = wave_sum(s) * (1.f / DM); float s2 = 0.f;
#pragma unroll
        for (int j = 0; j < 4; ++j) { v[j] = v[j] - mean; s2 += (v[j][0] * v[j][0] + v[j][1] * v[j][1]) + (v[j][2] * v[j][2] + v[j][3] * v[j][3]); }
        const float rstd = 1.f / sqrtf(wave_sum(s2) * (1.f / DM) + LN_EPS);
#pragma unroll
        for (int j = 0; j < 4; ++j) { v[j] = v[j] * rstd * g[j] + bt[j]; *(f32x4*)(xr + 4 * lane + 256 * j) = v[j];
            if (HB) { u32x2 w; w.x = pk2(v[j][0], v[j][1]); w.y = pk2(v[j][2], v[j][3]); *(u32x2*)(hb + (size_t)row * DM + 4 * lane + 256 * j) = w; } }
        if (FLOG) { float myv = 0.f;
#pragma unroll
            for (int h = 0; h < NH; ++h) { float d = 0.f;
#pragma unroll
                for (int j = 0; j < 4; ++j) { const f32x4 w = *(const LAS f32x4*)(wfl + h * DM + 4 * lane + 256 * j); d += (v[j][0] * w[0] + v[j][1] * w[1]) + (v[j][2] * w[2] + v[j][3] * w[3]); }
                d = wave_sum(d); if (lane == h) myv = d; }
            if (lane < NH) { const float z = myv + a.in[14][lane]; const float ls = fminf(z, 0.f) - log1pf(expf(-fabsf(z))); flog[(size_t)row * NH + lane] = ls; } }
    }
    if (FLOG) __syncthreads();
}
__device__ __forceinline__ f32x4 bflo(u32x4 w, int half) { const unsigned a = half ? w.z : w.x, b = half ? w.w : w.y;
    return (f32x4){__uint_as_float(a << 16), __uint_as_float(a & 0xffff0000u), __uint_as_float(b << 16), __uint_as_float(b & 0xffff0000u)}; }
__device__ __forceinline__ void conv_phase(const Args& a, int G) {
    int tid_ = threadIdx.x; asm volatile("" : "+v"(tid_)); const int lane = tid_ & 63, wave = __builtin_amdgcn_readfirstlane(tid_ >> 6); (void)lane; (void)wave;
    const int gtid = blockIdx.x * NTHR + tid_, NGT = G * NTHR;
    bf16* ub = (bf16*)(a.ws + WS_BIG); bf16* bb = ub + (size_t)MT * DM; const float* cw = a.in[11];
    constexpr int NGRP = TOK / 8 + 2;
    for (int item = gtid; item < NGRP * 128; item += NGT) { const int ch = item & 127, rg = item >> 7;
        int b, p0; if (rg < TOK / 8) { b = rg >> 10; p0 = 16 + (rg & 1023) * 8; } else { b = 0; p0 = (rg - TOK / 8) * 8; }
        const f32x4 w0a = *(const f32x4*)(cw + ch * 8), w0b = *(const f32x4*)(cw + ch * 8 + 4), w1a = *(const f32x4*)(cw + DM + ch * 8), w1b = *(const f32x4*)(cw + DM + ch * 8 + 4),
                    w2a = *(const f32x4*)(cw + 2 * DM + ch * 8), w2b = *(const f32x4*)(cw + 2 * DM + ch * 8 + 4);
        u32x4 um2 = {0u, 0u, 0u, 0u}, um1 = um2;
#define UROW(p) ((p) < 16 ? (size_t)(TOK + (p)) : (size_t)(b * SEQ + (p) - 16))
        if (p0 - 2 >= 0) um2 = *(const u32x4*)(ub + UROW(p0 - 2) * DM + ch * 8);
        if (p0 - 1 >= 0) um1 = *(const u32x4*)(ub + UROW(p0 - 1) * DM + ch * 8);
#pragma unroll
        for (int i = 0; i < 8; ++i) { const size_t ro = UROW(p0 + i) * DM + ch * 8;
            const u32x4 u0 = *(const u32x4*)(ub + ro), bg = *(const u32x4*)(bb + ro);
            const f32x4 ya = w0a * bflo(um2, 0) + w1a * bflo(um1, 0) + w2a * bflo(u0, 0), yb = w0b * bflo(um2, 1) + w1b * bflo(um1, 1) + w2b * bflo(u0, 1);
            *(u32x4*)(bb + ro) = pg8::pack8(bflo(bg, 0) * ya, bflo(bg, 1) * yb);
            um2 = um1; um1 = u0; }
#undef UROW
    }
}
__device__ __forceinline__ void scan_bh(const Args& a, LAS unsigned char* lds, int bh) {
    const float* flog = (const float*)(a.ws + WS_FLOG); float* cb = (float*)(a.ws + WS_CB) + (size_t)bh * KVPOS;
    int tid_ = threadIdx.x; asm volatile("" : "+v"(tid_));
    const int b = bh >> 3, h = bh & 7, tid = tid_, lane = tid & 63, wave = tid >> 6; LAS float* wtot = (LAS float*)lds;
    constexpr int PER = 17; float v[PER]; float s = 0.f;
#pragma unroll
    for (int i = 0; i < PER; ++i) { const int p = tid * PER + i; float x = 0.f;
        if (p < SEQ + NMETA) { const size_t row = p < 16 ? (size_t)(TOK + p) : (size_t)(b * SEQ + p - 16); x = flog[row * NH + h]; }
        s += x; v[i] = s; }
    float incl = s;
#pragma unroll
    for (int o = 1; o < 64; o <<= 1) { const float t = __shfl_up(incl, o); if (lane >= o) incl += t; }
    if (lane == 63) wtot[wave] = incl;
    __syncthreads();
    float base = incl - s;
    for (int w = 0; w < wave; ++w) base += wtot[w];
    const float NS = -11.313708498984761f;
#pragma unroll
    for (int i = 0; i < PER; ++i) { const int p = tid * PER + i; if (p < KVPOS) cb[p] = (p < SEQ + NMETA) ? NS * (base + v[i]) : 0.f; }
    __syncthreads();
}
#define XB_TMO      128
#define XB_XCNT(j)  (256  + 64 * (j))
#define XB_XSUB(j)  (1280 + 64 * (j))
#define XB_XGEN(j)  (2304 + 64 * (j))
#define XB_TOP      3328
#define XB_TOPGEN   3392
#define XCD_BAR_WORDS 3456
#define XB_SPIN_CAP (1u << 18)

__device__ __forceinline__ unsigned xb_ld(unsigned* p)              { return __hip_atomic_load(p, __ATOMIC_RELAXED, __HIP_MEMORY_SCOPE_AGENT); }
__device__ __forceinline__ unsigned xb_add(unsigned* p, unsigned v) { return __hip_atomic_fetch_add(p, v, __ATOMIC_RELAXED, __HIP_MEMORY_SCOPE_AGENT); }
__device__ __forceinline__ unsigned xb_xcc_id() { return (unsigned)__builtin_amdgcn_s_getreg((3 << 11) | 20) & 0xFu; }
#define XB_SPIN(cond, bar) do { unsigned _sp = 0; while (cond) { __builtin_amdgcn_s_sleep(1); \
    if ((++_sp & 255u) == 0u) { if (xb_ld(&(bar)[XB_TMO])) break; if (_sp > XB_SPIN_CAP) { atomicAdd(&(bar)[XB_TMO], 1u); break; } } } } while (0)

struct XcdBarrier {
    unsigned* bar; unsigned x;
    volatile LAS unsigned* st;
};

__device__ __forceinline__ XcdBarrier xcd_barrier_post(unsigned* bar, volatile LAS unsigned* st) {
    XcdBarrier b; b.bar = bar; b.x = xb_xcc_id(); b.st = st;
    if (threadIdx.x == 0) (void)xb_add(&bar[XB_XCNT(b.x)], 1u);
    return b;
}
__device__ __forceinline__ void xcd_barrier_complete(unsigned* bar, unsigned x, unsigned& nloc, unsigned& nx) {
    const unsigned G = gridDim.x * gridDim.y * gridDim.z;
    unsigned sum, cnt, mine, sp = 0u;
    for (;;) {
        sum = 0u; cnt = 0u; mine = 0u;
#pragma unroll
        for (unsigned j = 0; j < 16; ++j) { const unsigned c = xb_ld(&bar[XB_XCNT(j)]); sum += c; cnt += (c > 0u) ? 1u : 0u; mine = (j == x) ? c : mine; }
        if (sum == G) break;
        __builtin_amdgcn_s_sleep(1);
        if ((++sp & 255u) == 0u) { if (xb_ld(&bar[XB_TMO])) break; if (sp > XB_SPIN_CAP) { atomicAdd(&bar[XB_TMO], 1u); break; } }
    }
    nloc = mine > 0u ? mine : 1u; nx = cnt > 0u ? cnt : 1u;
}

__device__ __forceinline__ void xcd_barrier(const XcdBarrier& b) {
    asm volatile("s_waitcnt vmcnt(0)" ::: "memory");
    __syncthreads();
    if (threadIdx.x == 0) {
        unsigned* bar = b.bar;
        __builtin_amdgcn_s_waitcnt(0);
        unsigned nloc = b.st[0], nx = b.st[1];
        if (nloc == 0u) { xcd_barrier_complete(bar, b.x, nloc, nx); b.st[0] = nloc; b.st[1] = nx; }
        const unsigned old = xb_add(&bar[XB_XSUB(b.x)], 1u);
        const unsigned gen = old / nloc;
        if (old + 1u == (gen + 1u) * nloc) {
            __builtin_amdgcn_fence(__ATOMIC_RELEASE, "agent");
            asm volatile("s_waitcnt vmcnt(0)" ::: "memory");
            const unsigned og = xb_add(&bar[XB_TOP], 1u);
            const unsigned tg = og / nx;
            if (og + 1u == (tg + 1u) * nx) xb_add(&bar[XB_TOPGEN], 1u);
            else XB_SPIN(xb_ld(&bar[XB_TOPGEN]) == tg, bar);
            __builtin_amdgcn_fence(__ATOMIC_ACQUIRE, "agent");
            xb_add(&bar[XB_XGEN(b.x)], 1u);
            asm volatile("s_waitcnt vmcnt(0)" ::: "memory");
        } else {
            XB_SPIN(xb_ld(&bar[XB_XGEN(b.x)]) == gen, bar);
            __builtin_amdgcn_fence(__ATOMIC_ACQUIRE, "agent");
            asm volatile("s_waitcnt vmcnt(0)" ::: "memory");
        }
    }
    __syncthreads();
}

typedef att::BlockRef<att::bf16, att::bf16> ABlock;
__device__ __forceinline__ ABlock att_ref(const Args& a, int L, int pass) {
    const int bh = L >> 4, x = L & 15, qb = pass ? 31 - x : x, b = bh >> 3, h = bh & 7;
    const att::bf16* Q = (const att::bf16*)(a.ws + WS_BIG); att::bf16* O = (att::bf16*)(a.ws + WS_BIG + 32 * MiB);
    const att::bf16* K = (const att::bf16*)(a.ws + WS_W); const att::bf16* V = (const att::bf16*)(a.ws + WS_V);
    ABlock r; r.Q = Q + ((size_t)bh * SEQ + (size_t)qb * 256) * 128; r.K = K + (size_t)bh * KVPOS * 128; r.V = V + (size_t)bh * KVPOS * 128;
    r.O = O + ((size_t)b * SEQ + (size_t)qb * 256) * DM + h * 128; r.CB = (const float*)(a.ws + WS_CB) + (size_t)bh * KVPOS; r.P0 = NMETA + qb * 256;
    return r;
}
__device__ __forceinline__ void attn_phase(const Args& a, char* lds, int vcu, int G) {
    constexpr int total = 256, W = 1 << 30;
    int L = vcu; if (L >= total) return;
    int pass = 0; ABlock cur = att_ref(a, L, 0);
    att::Seam<att::bf16> S;
    att::causal_swa_prime<att::bf16, att::bf16>(cur, W, lds, S);
    for (;;) {
        const bool more_pass = pass == 0, more_item = L + G < total, last = !more_pass && !more_item;
        int passn = pass + 1, Ln = L;
        if (!more_pass) { passn = 0; Ln = more_item ? L + G : L; }
        const ABlock nxt = last ? cur : att_ref(a, Ln, passn);
        att::causal_swa_block<att::bf16, att::bf16>(cur, nxt, KVPOS, W, lds, S);
        if (last) break;
        cur = nxt; pass = passn; L = Ln;
    }
}

__global__ void __launch_bounds__(NTHR, 2) yoco_fwd(Args a) {
    extern __shared__ __attribute__((aligned(16))) unsigned char lds_raw[];
    cg::grid_group grid = cg::this_grid();
    LAS unsigned char* lds = (LAS unsigned char*)lds_raw;
    if (threadIdx.x < 64) ((LAS unsigned*)(lds + LDS_PHASE))[threadIdx.x] = 0u;
    __syncthreads();
    XcdBarrier bar = xcd_barrier_post((unsigned*)a.ws, (volatile LAS unsigned*)(lds + LDS_PHASE));
    const int G = gridDim.x, bx = blockIdx.x, vcu = (G % 8 == 0) ? (bx % 8) * (G / 8) + bx / 8 : bx;
    bf16* WT = (bf16*)(a.ws + WS_W); bf16* hb = (bf16*)(a.ws + WS_HB); bf16* big = (bf16*)(a.ws + WS_BIG);
    float* Xm = (float*)(a.ws + WS_XM);
    const float* lng = a.in[8]; const float* lnb = a.in[9];
#define GEMM(EpiT, E_, A_, B_, M_, N_, K_) do { pg8::Gemm g_{(A_), (B_), (M_), (N_), (K_)}; pg8::StaticOrder S_; S_.init((M_), (N_), G, bx); \
        pg8::gemm_phase<EpiT, pg8::StaticOrder, true, true>(lds, g_, S_, (E_)); } while (0)

    p0_prologue(a, lds, vcu, G);
    grid.sync();
    { pg8::EpiSwiglu E{big, FF}; GEMM(pg8::EpiSwiglu, E, hb, WT + W_UP10, MT, 2 * FF, DM); }
    xcd_barrier(bar);
    { pg8::EpiResid E{a.in[0], a.out, Xm, Xm, 0.5f}; GEMM(pg8::EpiResid, E, big, WT + W_DN10, MT, DM, FF); }
    xcd_barrier(bar);
    ln_phase<true, false>(a, lds, TOK + NMETA, lng + 0 * DM, lnb + 0 * DM, vcu, G);
    xcd_barrier(bar);
    { pg8::EpiConvIn E{big, big + (size_t)MT * DM}; GEMM(pg8::EpiConvIn, E, hb, WT + W_CIN, MT, 3 * DM, DM); }
    xcd_barrier(bar);
    conv_phase(a, G);
    xcd_barrier(bar);
    { pg8::EpiResid E{a.out, a.out, Xm, Xm, 1.0f}; GEMM(pg8::EpiResid, E, big + (size_t)MT * DM, WT + W_COUT, MT, DM, DM); }
    xcd_barrier(bar);
    ln_phase<true, false>(a, lds, TOK + NMETA, lng + 1 * DM, lnb + 1 * DM, vcu, G);
    xcd_barrier(bar);
    { pg8::EpiSwiglu E{big, FF}; GEMM(pg8::EpiSwiglu, E, hb, WT + W_UP20, MT, 2 * FF, DM); }
    xcd_barrier(bar);
    { pg8::EpiResid E{a.out, a.out, Xm, Xm, 0.5f}; GEMM(pg8::EpiResid, E, big, WT + W_DN20, MT, DM, FF); }
    xcd_barrier(bar);
    ln_phase<true, true>(a, lds, TOK + NMETA, lng + 2 * DM, lnb + 2 * DM, vcu, G);
    xcd_barrier(bar);
    { pg8::EpiKV E{WT  , (bf16*)(a.ws + WS_V)}; GEMM(pg8::EpiKV, E, hb, WT + W_KV, MT, 2 * DM, DM); }
    { pg8::EpiSwiglu E{big, FF}; GEMM(pg8::EpiSwiglu, E, hb, WT + W_UP11, TOK, 2 * FF, DM); }
    for (int bh = G - 1 - bx; bh < 2 * NH; bh += G) scan_bh(a, lds, bh);
    xcd_barrier(bar);
    { pg8::EpiResid E{a.out, a.out, Xm, Xm, 0.5f}; GEMM(pg8::EpiResid, E, big, WT + W_DN11, TOK, DM, FF); }
    xcd_barrier(bar);
    ln_phase<true, false>(a, lds, TOK, lng + 3 * DM, lnb + 3 * DM, vcu, G);
    xcd_barrier(bar);
    { pg8::EpiQ E{big}; GEMM(pg8::EpiQ, E, hb, WT + W_Q, TOK, DM, DM); }
    xcd_barrier(bar);
    attn_phase(a, (char*)lds_raw, vcu, G);
    xcd_barrier(bar);
    { pg8::EpiResid E{a.out, a.out, Xm, Xm, 1.0f}; GEMM(pg8::EpiResid, E, big + (size_t)16 * MiB  , WT + W_O, TOK, DM, DM); }
    xcd_barrier(bar);
    ln_phase<true, false>(a, lds, TOK, lng + 4 * DM, lnb + 4 * DM, vcu, G);
    xcd_barrier(bar);
    { pg8::EpiSwiglu E{big, FF}; GEMM(pg8::EpiSwiglu, E, hb, WT + W_UP21, TOK, 2 * FF, DM); }
    xcd_barrier(bar);
    { pg8::EpiResid E{a.out, a.out, Xm, Xm, 0.5f}; GEMM(pg8::EpiResid, E, big, WT + W_DN21, TOK, DM, FF); }
    xcd_barrier(bar);
    ln_phase<false, false>(a, lds, TOK, lng + 5 * DM, lnb + 5 * DM, vcu, G);
#undef GEMM
}

extern "C" void kernel_launch(void* const* d_in, const int* in_sizes, int n_in, void* d_out, int out_size, void* d_ws, size_t ws_size, hipStream_t stream) {
    static int grid = 0;
    if (grid == 0) {
        if (n_in != 17 || in_sizes[0] != TOK * DM || out_size != TOK * DM || ws_size < WS_END) {
            fprintf(stderr, "kernel_launch: unexpected shapes (n_in %d, in0 %d, out %d, ws %zu); nothing launched\n", n_in, n_in > 0 ? in_sizes[0] : -1, out_size, ws_size); grid = -1; return; }
        int dev = 0, cus = 0, per_cu = 0;
        (void)hipGetDevice(&dev); (void)hipDeviceGetAttribute(&cus, hipDeviceAttributeMultiprocessorCount, dev);
        if (hipFuncSetAttribute((const void*)yoco_fwd, hipFuncAttributeMaxDynamicSharedMemorySize, LDS_TOTAL) != hipSuccess) { fprintf(stderr, "kernel_launch: hipFuncSetAttribute failed\n"); grid = -1; return; }
        if (hipOccupancyMaxActiveBlocksPerMultiprocessor(&per_cu, (const void*)yoco_fwd, NTHR, LDS_TOTAL) != hipSuccess || per_cu < 1) { fprintf(stderr, "kernel_launch: occupancy query says %d blocks/CU\n", per_cu); grid = -1; return; }
        grid = cus;
    }
    if (grid < 0) return;
    if (hipMemsetAsync(d_ws, 0, 65536, stream) != hipSuccess) { fprintf(stderr, "kernel_launch: memset failed\n"); return; }
    Args a{};
    for (int i = 0; i < 17; ++i) a.in[i] = (const float*)d_in[i];
    a.out = (float*)d_out; a.ws = (unsigned char*)d_ws;
    void* args[] = {&a};
    hipError_t e = hipLaunchCooperativeKernel((const void*)yoco_fwd, dim3(grid), dim3(NTHR), args, LDS_TOTAL, stream);
    if (e != hipSuccess) fprintf(stderr, "kernel_launch: cooperative launch failed: %s (grid %d)\n", hipGetErrorString(e), grid);
}
```

```cpp
#include <hip/hip_runtime.h>
#include <hip/hip_bf16.h>
#include <hip/hip_cooperative_groups.h>
#include <cstdio>
#include <cstdint>
namespace cg = cooperative_groups;

namespace pg8 {
#define PG8_LAS __attribute__((address_space(3)))
typedef unsigned short bf16_t;
typedef short bf16x8 __attribute__((ext_vector_type(8)));
typedef float f32x4 __attribute__((ext_vector_type(4)));
typedef unsigned u32x4 __attribute__((ext_vector_type(4)));
constexpr int BM = 256, BK = 64, HALF = 128, HTB = HALF * BK * 2  , STAGE_BYTES = 8 * HTB, NXCD = 8, WGM = 8;

__host__ __device__ __forceinline__ int lds_byte(int r, int c) { const int st = (r >> 4) * 2 + (c >> 5), rr = r & 15, cc = c & 31, ob = rr * 64 + cc * 2; return st * 1024 + (ob ^ (((ob >> 9) & 1) << 5)); }
__host__ __device__ __forceinline__ void stage_rc(int b, int& R, int& C) { const int st = b / 1024, sb = b % 1024, swz = sb ^ (((sb >> 9) & 1) << 5); R = (st >> 1) * 16 + swz / 64; C = (st & 1) * 32 + (swz % 64) / 2; }
__host__ __device__ __forceinline__ int perm32(int rho) { const int n = rho >> 4, i = rho & 15; return 8 * (i >> 2) + 4 * n + (i & 3); }

struct Unit { int pm, pn; };
struct Gemm { const bf16_t* A; const bf16_t* Bt; int M, N, K; };

struct StaticOrder {
    int nM, nN, nwg, G, c;
    __host__ __device__ void init(int M, int N, int G_, int c_) { nM = M / BM; nN = N / BM; nwg = nM * nN; G = G_; c = c_; }
    __host__ __device__ bool next(int i, Unit& u) const {
        const long L = (long)i * G + c; if (L >= nwg) return false;
        int wgid = (int)L; { const int q = nwg / NXCD, r = nwg % NXCD, xcd = wgid % NXCD, off = wgid / NXCD; wgid = (xcd < r ? xcd * (q + 1) : r * (q + 1) + (xcd - r) * q) + off; }
        const int nig = WGM * nN, gid = wgid / nig, fm = gid * WGM, gsz = (nM - fm) < WGM ? (nM - fm) : WGM;
        u.pm = fm + ((wgid % nig) % gsz); u.pn = (wgid % nig) / gsz; return true;
    }
    __device__ __forceinline__ void a_ready(const Unit&) const {}
    __device__ __forceinline__ void done(const Unit&) const {}
};
__device__ __forceinline__ unsigned cvt_pk_bf16(float lo, float hi) { unsigned r; asm volatile("v_cvt_pk_bf16_f32 %0, %1, %2" : "=v"(r) : "v"(lo), "v"(hi)); return r; }
__device__ __forceinline__ u32x4 pack8(f32x4 a, f32x4 b) { u32x4 w; w.x = cvt_pk_bf16(a[0], a[1]); w.y = cvt_pk_bf16(a[2], a[3]); w.z = cvt_pk_bf16(b[0], b[1]); w.w = cvt_pk_bf16(b[2], b[3]); return w; }
__device__ __forceinline__ float silu_mul(float g, float u) { return g * __builtin_amdgcn_rcpf(1.0f + __builtin_amdgcn_exp2f(-1.4426950408889634f * g)) * u; }
__device__ __forceinline__ f32x4 silu_mul4(f32x4 g, f32x4 u) { return (f32x4){silu_mul(g[0], u[0]), silu_mul(g[1], u[1]), silu_mul(g[2], u[2]), silu_mul(g[3], u[3])}; }
constexpr int TOKROWS = 16384;
struct EpiSwiglu {
    static constexpr bool PERM = true, AFTER_DRAIN = false;
    bf16_t* act; int ldc;
    __device__ __forceinline__ void operator()(const f32x4 (&acc)[2][2][4][2], const Unit& u, int wr, int wc, int fr, int fq) const {
        const int row0 = u.pm * BM + wr * 64 + fr, col = u.pn * 128 + wc * 32 + 8 * fq;
#pragma unroll
        for (int ai = 0; ai < 2; ++ai)
#pragma unroll
            for (int m = 0; m < 4; ++m) { bf16_t* p = act + (size_t)(row0 + ai * HALF + m * 16) * ldc + col;
                *(u32x4*)p = pack8(silu_mul4(acc[ai][0][m][0], acc[ai][1][m][0]), silu_mul4(acc[ai][0][m][1], acc[ai][1][m][1])); }
    }
};
struct EpiResid {
    static constexpr bool PERM = true, AFTER_DRAIN = false;
    const float* src; float* dst; const float* src_m; float* dst_m; float scale;
    __device__ __forceinline__ void operator()(const f32x4 (&acc)[2][2][4][2], const Unit& u, int wr, int wc, int fr, int fq) const {
        const bool meta = u.pm * BM >= TOKROWS;
        const float* s = meta ? src_m : src + (size_t)u.pm * BM * 1024; float* d = meta ? dst_m : dst + (size_t)u.pm * BM * 1024;
        const int r0 = wr * 64 + fr, c0 = u.pn * BM + wc * 32 + 8 * fq; const float ALPHA = 1.4142135623730951f;
#pragma unroll
        for (int ai = 0; ai < 2; ++ai)
#pragma unroll
            for (int m = 0; m < 4; ++m)
#pragma unroll
                for (int bj = 0; bj < 2; ++bj) { const size_t off = (size_t)(r0 + ai * HALF + m * 16) * 1024 + c0 + bj * HALF;
                    const f32x4 a0 = *(const f32x4*)(s + off), a1 = *(const f32x4*)(s + off + 4);
                    *(f32x4*)(d + off) = a0 * ALPHA + acc[ai][bj][m][0] * scale; *(f32x4*)(d + off + 4) = a1 * ALPHA + acc[ai][bj][m][1] * scale; }
    }
};
struct EpiConvIn {
    static constexpr bool PERM = true, AFTER_DRAIN = false;
    bf16_t* ub; bf16_t* bb;
    __device__ __forceinline__ void operator()(const f32x4 (&acc)[2][2][4][2], const Unit& u, int wr, int wc, int fr, int fq) const {
        const int row0 = u.pm * BM + wr * 64 + fr;
        if (u.pn < 8) { const int col = u.pn * 128 + wc * 32 + 8 * fq;
#pragma unroll
            for (int ai = 0; ai < 2; ++ai)
#pragma unroll
                for (int m = 0; m < 4; ++m) *(u32x4*)(ub + (size_t)(row0 + ai * HALF + m * 16) * 1024 + col) = pack8(acc[ai][0][m][0] * acc[ai][1][m][0], acc[ai][0][m][1] * acc[ai][1][m][1]);
        } else { const int col = (u.pn - 8) * BM + wc * 32 + 8 * fq;
#pragma unroll
            for (int ai = 0; ai < 2; ++ai)
#pragma unroll
                for (int m = 0; m < 4; ++m)
#pragma unroll
                    for (int bj = 0; bj < 2; ++bj) *(u32x4*)(bb + (size_t)(row0 + ai * HALF + m * 16) * 1024 + col + bj * HALF) = pack8(acc[ai][bj][m][0], acc[ai][bj][m][1]);
        }
    }
};
constexpr int KVPOS = 8256;
struct EpiKV {
    static constexpr bool PERM = true, AFTER_DRAIN = false;
    bf16_t* Kb; bf16_t* Vb;
    __device__ __forceinline__ void operator()(const f32x4 (&acc)[2][2][4][2], const Unit& u, int wr, int wc, int fr, int fq) const {
        bf16_t* base = (u.pn < 4) ? Kb : Vb; const int h0 = (u.pn & 3) * 2, d = wc * 32 + 8 * fq;
        if (u.pm * BM < TOKROWS) {
#pragma unroll
            for (int ai = 0; ai < 2; ++ai)
#pragma unroll
                for (int m = 0; m < 4; ++m) { const int r = u.pm * BM + ai * HALF + wr * 64 + m * 16 + fr, b = r >> 13, t = r & 8191;
#pragma unroll
                    for (int bj = 0; bj < 2; ++bj) *(u32x4*)(base + ((size_t)(b * 8 + h0 + bj) * KVPOS + 16 + t) * 128 + d) = pack8(acc[ai][bj][m][0], acc[ai][bj][m][1]); }
        } else if (wr == 0) {
#pragma unroll
            for (int bj = 0; bj < 2; ++bj) { const u32x4 w = pack8(acc[0][bj][0][0], acc[0][bj][0][1]);
                *(u32x4*)(base + ((size_t)(0 * 8 + h0 + bj) * KVPOS + fr) * 128 + d) = w; *(u32x4*)(base + ((size_t)(1 * 8 + h0 + bj) * KVPOS + fr) * 128 + d) = w; }
        }
    }
};
struct EpiQ {
    static constexpr bool PERM = true, AFTER_DRAIN = false;
    bf16_t* Q;
    __device__ __forceinline__ void operator()(const f32x4 (&acc)[2][2][4][2], const Unit& u, int wr, int wc, int fr, int fq) const {
        const int h0 = u.pn * 2, d = wc * 32 + 8 * fq;
#pragma unroll
        for (int ai = 0; ai < 2; ++ai)
#pragma unroll
            for (int m = 0; m < 4; ++m) { const int r = u.pm * BM + ai * HALF + wr * 64 + m * 16 + fr, b = r >> 13, t = r & 8191;
#pragma unroll
                for (int bj = 0; bj < 2; ++bj) *(u32x4*)(Q + ((size_t)(b * 8 + h0 + bj) * 8192 + t) * 128 + d) = pack8(acc[ai][bj][m][0], acc[ai][bj][m][1]); }
    }
};

template <class Epi, class Sched, bool ALIGN_EPI = false, bool SP2 = false>
__device__ __forceinline__ void gemm_phase(PG8_LAS unsigned char* lds, const Gemm g, const Sched& S, const Epi& E) {
    int tid_ = threadIdx.x; asm volatile("" : "+v"(tid_));
    const int tid = tid_, wid = __builtin_amdgcn_readfirstlane(tid >> 6), lane = tid & 63, wr = wid >> 2, wc = wid & 3, fr = lane & 15, fq = lane >> 4;
    const int K = g.K, nt = K / BK;
    unsigned voffA[2], voffB[2];
#pragma unroll
    for (int i = 0; i < 2; ++i) { int R, C; stage_rc(tid * 16 + i * 8192, R, C); const int Rb = Epi::PERM ? ((R & ~31) + perm32(R & 31)) : R;
        voffA[i] = (unsigned)(R * K + C) * 2u; voffB[i] = (unsigned)(Rb * K + C) * 2u; }
    const size_t kstep = (size_t)(BK * 2);
    const size_t hstep = (size_t)HALF * K * 2;
    const size_t tstep = 2 * hstep;
    const unsigned ldsw = (unsigned)wid * 1024u;
    const int aoff = lds_byte(wr * 64 + fr, fq * 8), boff = lds_byte(wc * 32 + fr, fq * 8);
#define PG8_SA(b, h) (((b) * 2 + (h)) * HTB)
#define PG8_SB(b, h) ((4 + (b) * 2 + (h)) * HTB)
#define PG8_STAGE(bufoff, gbase, voff) do { _Pragma("unroll") for (int _i = 0; _i < 2; ++_i) \
        __builtin_amdgcn_global_load_lds((const unsigned*)((const char*)(gbase) + (voff)[_i]), (PG8_LAS unsigned*)(lds + (bufoff) + ldsw + _i * 8192), 16, 0, 0); } while (0)
#define PG8_LDA(dst, b, h) do { _Pragma("unroll") for (int m = 0; m < 4; ++m) _Pragma("unroll") for (int k = 0; k < 2; ++k) dst[m][k] = *(const PG8_LAS bf16x8*)(lds + PG8_SA(b, h) + aoff + m * 2048 + k * 1024); } while (0)
#define PG8_LDB(dst, b, h) do { _Pragma("unroll") for (int n = 0; n < 2; ++n) _Pragma("unroll") for (int k = 0; k < 2; ++k) dst[n][k] = *(const PG8_LAS bf16x8*)(lds + PG8_SB(b, h) + boff + n * 2048 + k * 1024); } while (0)
#define PG8_MMA(ai, bj, At, Bt) do { __builtin_amdgcn_s_setprio(1); _Pragma("unroll") for (int m = 0; m < 4; ++m) _Pragma("unroll") for (int n = 0; n < 2; ++n) _Pragma("unroll") for (int k = 0; k < 2; ++k) \
        acc[ai][bj][m][n] = __builtin_amdgcn_mfma_f32_16x16x32_bf16(Bt[n][k], At[m][k], acc[ai][bj][m][n], 0, 0, 0); __builtin_amdgcn_s_setprio(0); } while (0)
#define PG8_WAIT_V(n) asm volatile("s_waitcnt vmcnt(" #n ")" ::: "memory")
#define PG8_WAIT_L(n) asm volatile("s_waitcnt lgkmcnt(" #n ")" ::: "memory")
#define PG8_BAR __builtin_amdgcn_s_barrier()
#define PG8_SCHED __builtin_amdgcn_sched_barrier(0)
    Unit cur, nxt; int ui = 0;
    if (!S.next(0, cur)) return;
    f32x4 acc[2][2][4][2];
#pragma unroll
    for (int a = 0; a < 2; ++a)
#pragma unroll
        for (int b = 0; b < 2; ++b)
#pragma unroll
            for (int m = 0; m < 4; ++m)
#pragma unroll
                for (int n = 0; n < 2; ++n) acc[a][b][m][n] = (f32x4){0.f, 0.f, 0.f, 0.f};
    bf16x8 At[4][2], B0[2][2], B1[2][2];
    const char* cA = (const char*)g.A + (size_t)cur.pm * tstep; const char* cB = (const char*)g.Bt + (size_t)cur.pn * tstep;
    S.a_ready(cur);
    if constexpr (SP2) {
        PG8_STAGE(PG8_SB(0, 0), cB, voffB); PG8_STAGE(PG8_SB(0, 1), cB + hstep, voffB); PG8_STAGE(PG8_SA(0, 0), cA, voffA); PG8_STAGE(PG8_SA(0, 1), cA + hstep, voffA);
        if (wr == 1) PG8_BAR;
        PG8_WAIT_V(2); PG8_BAR;
        PG8_STAGE(PG8_SB(1, 0), cB + kstep, voffB); PG8_STAGE(PG8_SA(1, 0), cA + kstep, voffA); PG8_STAGE(PG8_SB(1, 1), cB + hstep + kstep, voffB);
        PG8_WAIT_V(6); PG8_BAR;
    } else {
        PG8_STAGE(PG8_SB(0, 0), cB, voffB); PG8_STAGE(PG8_SA(0, 0), cA, voffA); PG8_STAGE(PG8_SB(0, 1), cB + hstep, voffB); PG8_STAGE(PG8_SA(0, 1), cA + hstep, voffA);
        if (wr == 1) PG8_BAR;
        PG8_WAIT_V(4); PG8_BAR;
        PG8_STAGE(PG8_SB(1, 0), cB + kstep, voffB); PG8_STAGE(PG8_SA(1, 0), cA + kstep, voffA); PG8_STAGE(PG8_SB(1, 1), cB + hstep + kstep, voffB);
        PG8_WAIT_V(6); PG8_BAR;
    }
    for (;;) {
        const bool has_next = S.next(ui + 1, nxt);
        const char* nA = has_next ? (const char*)g.A + (size_t)nxt.pm * tstep : cA; const char* nB = has_next ? (const char*)g.Bt + (size_t)nxt.pn * tstep : cB;
        for (int t = 0; t < nt; t += 2) {
            const bool last = (t == nt - 2);
            const char* a1 = cA + (size_t)(t + 1) * kstep;
            const char* a2 = last ? nA : cA + (size_t)(t + 2) * kstep; const char* b2 = last ? nB : cB + (size_t)(t + 2) * kstep;
            const char* a3 = a2 + kstep; const char* b3 = b2 + kstep;
            if (last && has_next) S.a_ready(nxt);
            if constexpr (SP2) {
            PG8_LDB(B0, 0, 0); PG8_LDB(B1, 0, 1); PG8_SCHED; PG8_LDA(At, 0, 0); PG8_STAGE(PG8_SA(1, 1), a1 + hstep, voffA);
            PG8_WAIT_V(8); PG8_WAIT_L(0); PG8_BAR; PG8_MMA(0, 0, At, B0); PG8_MMA(0, 1, At, B1); PG8_BAR; PG8_SCHED;
            PG8_LDA(At, 0, 1); PG8_STAGE(PG8_SB(0, 0), b2, voffB); PG8_STAGE(PG8_SB(0, 1), b2 + hstep, voffB); PG8_STAGE(PG8_SA(0, 0), a2, voffA);
            PG8_WAIT_V(8); PG8_WAIT_L(0); PG8_BAR; PG8_MMA(1, 0, At, B0); PG8_MMA(1, 1, At, B1); PG8_BAR; PG8_SCHED;
            PG8_LDB(B0, 1, 0); PG8_LDB(B1, 1, 1); PG8_SCHED; PG8_LDA(At, 1, 0); PG8_STAGE(PG8_SA(0, 1), a2 + hstep, voffA);
            PG8_WAIT_V(8); PG8_WAIT_L(0); PG8_BAR; PG8_MMA(0, 0, At, B0); PG8_MMA(0, 1, At, B1); PG8_BAR; PG8_SCHED;
            PG8_LDA(At, 1, 1); PG8_STAGE(PG8_SB(1, 0), b3, voffB); PG8_STAGE(PG8_SB(1, 1), b3 + hstep, voffB); PG8_STAGE(PG8_SA(1, 0), a3, voffA);
            PG8_WAIT_V(8); PG8_WAIT_L(0); PG8_BAR; PG8_MMA(1, 0, At, B0); PG8_MMA(1, 1, At, B1); PG8_BAR; PG8_SCHED;
            } else {
            PG8_LDB(B0, 0, 0); PG8_SCHED; PG8_LDA(At, 0, 0); PG8_STAGE(PG8_SA(1, 1), a1 + hstep, voffA);
            PG8_WAIT_L(8); PG8_BAR; PG8_WAIT_L(0); PG8_MMA(0, 0, At, B0); PG8_BAR; PG8_SCHED;
            PG8_LDB(B1, 0, 1); PG8_STAGE(PG8_SB(0, 0), b2, voffB);
            PG8_BAR; PG8_WAIT_L(0); PG8_MMA(0, 1, At, B1); PG8_BAR;
            PG8_LDA(At, 0, 1); PG8_STAGE(PG8_SA(0, 0), a2, voffA);
            PG8_BAR; PG8_WAIT_L(0); PG8_MMA(1, 0, At, B0); PG8_BAR; PG8_SCHED;
            PG8_STAGE(PG8_SB(0, 1), b2 + hstep, voffB);
            PG8_WAIT_V(6); PG8_BAR; PG8_MMA(1, 1, At, B1); PG8_BAR;
            PG8_LDB(B0, 1, 0); PG8_SCHED; PG8_LDA(At, 1, 0); PG8_STAGE(PG8_SA(0, 1), a2 + hstep, voffA);
            PG8_WAIT_L(8); PG8_BAR; PG8_WAIT_L(0); PG8_MMA(0, 0, At, B0); PG8_BAR; PG8_SCHED;
            PG8_LDB(B1, 1, 1); PG8_STAGE(PG8_SB(1, 0), b3, voffB);
            PG8_BAR; PG8_WAIT_L(0); PG8_MMA(0, 1, At, B1); PG8_BAR;
            PG8_LDA(At, 1, 1); PG8_STAGE(PG8_SA(1, 0), a3, voffA);
            PG8_BAR; PG8_WAIT_L(0); PG8_MMA(1, 0, At, B0); PG8_BAR; PG8_SCHED;
            PG8_STAGE(PG8_SB(1, 1), b3 + hstep, voffB);
            PG8_WAIT_V(6); PG8_BAR; PG8_MMA(1, 1, At, B1); PG8_BAR;
            }
        }
        if constexpr (ALIGN_EPI) { if (wr == 0) PG8_BAR; }
        if constexpr (!Epi::AFTER_DRAIN) { E(acc, cur, wr, wc, fr, fq); S.done(cur); }
        if (!has_next) break;
#pragma unroll
        for (int a = 0; a < 2; ++a)
#pragma unroll
            for (int b = 0; b < 2; ++b)
#pragma unroll
                for (int m = 0; m < 4; ++m)
#pragma unroll
                    for (int n = 0; n < 2; ++n) acc[a][b][m][n] = (f32x4){0.f, 0.f, 0.f, 0.f};
        cur = nxt; cA = nA; cB = nB; ++ui;
        if constexpr (ALIGN_EPI) { if (wr == 1) PG8_BAR; }
    }
    PG8_WAIT_V(0);
    if constexpr (!ALIGN_EPI) { if (wr == 0) PG8_BAR; }
    PG8_BAR;
    if constexpr (Epi::AFTER_DRAIN) { E.fused(acc, cur, wr, wc, fr, fq, lds, wid, lane); S.done(cur); }
#undef PG8_SA
#undef PG8_SB
#undef PG8_STAGE
#undef PG8_LDA
#undef PG8_LDB
#undef PG8_MMA
#undef PG8_WAIT_V
#undef PG8_WAIT_L
#undef PG8_BAR
#undef PG8_SCHED
}
}
namespace att {
#define ALAS __attribute__((address_space(3)))
constexpr int D = 128, OSTR = 1024;
constexpr float THR = 8.f;
constexpr bool WSKIP = false;
constexpr float SCALE = 0.08838834764831845f;
constexpr int NW = 8, QBLK = 32, KVBLK = 64, QB = NW * QBLK;
constexpr int SHM_V = KVBLK * D * 2, SHM_K = KVBLK * D * 2;
constexpr int CB_FLOATS = 8256;
constexpr int LDS_BYTES = 2 * SHM_V + 2 * SHM_K + NW * 64 * 4 + CB_FLOATS * 4;
using bf16 = __hip_bfloat16;
typedef short bf16x8 __attribute__((ext_vector_type(8)));
typedef short s16x4 __attribute__((ext_vector_type(4)));
typedef float f32x16 __attribute__((ext_vector_type(16)));
typedef float f32x4 __attribute__((ext_vector_type(4)));
typedef unsigned u32x4 __attribute__((ext_vector_type(4)));
template <class A, class Bt> struct same_t { static constexpr bool v = false; };
template <class A> struct same_t<A, A> { static constexpr bool v = true; };
#define KSWZ(row, colB) ((row) * 256 + ((colB) ^ (((row) & 7) << 4)))
#define SBAR() __builtin_amdgcn_sched_barrier(0)
__device__ __forceinline__ int v_st(int k, int c) { const int kk = (k & ~0xC) | ((k & 4) << 1) | ((k & 8) >> 1); return ((kk >> 3) * 4 + (c >> 5)) * 512 + ((kk & 7) * 32 + (c & 31)) * 2; }
__device__ __forceinline__ int v_rd_base(int lane) { return ((lane & 3) << 3) | (((lane >> 2) & 3) << 6) | (((lane >> 4) & 1) << 5) | (((lane >> 5) & 1) << 8); }
constexpr int v_rd_off(int d0, int ks, int half) { return d0 * 512 + ks * 4096 + half * 2048; }
__device__ __forceinline__ int crow(int r, int hi) { return (r & 3) + 8 * (r >> 2) + 4 * hi; }
__device__ __forceinline__ unsigned cvtpk(float lo, float hi) {
    unsigned r; asm volatile("v_cvt_pk_bf16_f32 %0, %1, %2" : "=v"(r) : "v"(lo), "v"(hi)); return r;
}
__device__ __forceinline__ bf16x8 pack8(f32x4 a, f32x4 b) {
    u32x4 w = {cvtpk(a[0], a[1]), cvtpk(a[2], a[3]), cvtpk(b[0], b[1]), cvtpk(b[2], b[3])};
    return *reinterpret_cast<bf16x8*>(&w);
}
template <class T> __device__ __forceinline__ bf16x8 load8(const T* p) {
    if constexpr (same_t<T, float>::v) { return pack8(*(const f32x4*)p, *(const f32x4*)(p + 4)); }
    else { return *reinterpret_cast<const bf16x8*>(p); }
}
__device__ __forceinline__ void mask_tile(f32x16& p0, f32x16& p1, int dq, unsigned W) {
    const float NEG = -__builtin_inff();
#pragma unroll
    for (int r = 0; r < 16; ++r) {
        const int c = (r & 3) + 8 * (r >> 2);
        if ((unsigned)(dq - c) >= W) p0[r] = NEG;
        if ((unsigned)(dq - c - 32) >= W) p1[r] = NEG;
    }
}
__device__ __forceinline__ void partialSM(f32x16& p0, f32x16& p1, float& m_reg, float& mn, float& alpha) {
    float pmax = p0[0]; for (int r = 1; r < 16; ++r) pmax = fmaxf(pmax, p0[r]); for (int r = 0; r < 16; ++r) pmax = fmaxf(pmax, p1[r]);
    { auto rr = __builtin_amdgcn_permlane32_swap(__float_as_uint(pmax), __float_as_uint(pmax), false, false);
      pmax = fmaxf(__uint_as_float(rr[0]), __uint_as_float(rr[1])); }
    constexpr float C2 = 1.4426950408889634f * SCALE;
    if (__builtin_expect(__all((pmax - m_reg) * SCALE <= THR), 1)) { mn = m_reg; alpha = 1.f; }
    else { mn = fmaxf(m_reg, pmax); alpha = __builtin_amdgcn_exp2f((m_reg - mn) * C2); m_reg = mn; }
    const float mnL = -mn * C2;
    for (int r = 0; r < 16; ++r) p0[r] = fmaf(p0[r], C2, mnL); for (int r = 0; r < 16; ++r) p1[r] = fmaf(p1[r], C2, mnL);
    for (int r = 0; r < 16; ++r) p0[r] = __builtin_amdgcn_exp2f(p0[r]);
}
__device__ __forceinline__ void finishSM(f32x16& p0, f32x16& p1, float alpha, float& l_reg, bf16x8& pa0, bf16x8& pa1, bf16x8& pa2, bf16x8& pa3) {
    for (int r = 0; r < 16; ++r) p1[r] = __builtin_amdgcn_exp2f(p1[r]);
    float ps = 0; for (int r = 0; r < 16; ++r) ps += p0[r]; for (int r = 0; r < 16; ++r) ps += p1[r];
    { auto rr = __builtin_amdgcn_permlane32_swap(__float_as_uint(ps), __float_as_uint(ps), false, false);
      ps = __uint_as_float(rr[0]) + __uint_as_float(rr[1]); }
    l_reg = l_reg * alpha + ps;
#define PK4(P, B_, OUT) do { unsigned a0 = cvtpk(P[B_+0], P[B_+1]), a1 = cvtpk(P[B_+2], P[B_+3]);                          \
        unsigned b0 = cvtpk(P[B_+4], P[B_+5]), b1 = cvtpk(P[B_+6], P[B_+7]);                                             \
        auto r0 = __builtin_amdgcn_permlane32_swap(a0, b0, false, false); auto r1 = __builtin_amdgcn_permlane32_swap(a1, b1, false, false); \
        u32x4 w = {r0[0], r1[0], r0[1], r1[1]}; OUT = *reinterpret_cast<bf16x8*>(&w); } while (0)
    PK4(p0, 0, pa0); PK4(p0, 8, pa1); PK4(p1, 0, pa2); PK4(p1, 8, pa3);
#undef PK4
}
template <int KB, bool SK>
__device__ __forceinline__ void qkt(f32x16& p0, f32x16& p1, const char* K_lds, int r32, int hi, const bf16x8* qr, bool act, const ALAS float* cbt) {
    if (SK && !act) { const float NEG = -__builtin_inff();
#pragma unroll
        for (int r = 0; r < 16; ++r) { p0[r] = NEG; p1[r] = NEG; } return; }
#pragma unroll
    for (int g = 0; g < 4; ++g) { const f32x4 ba = *(const ALAS f32x4*)(cbt + 8 * g), bb = *(const ALAS f32x4*)(cbt + 32 + 8 * g);
        p0[4 * g] = ba[0]; p0[4 * g + 1] = ba[1]; p0[4 * g + 2] = ba[2]; p0[4 * g + 3] = ba[3]; p1[4 * g] = bb[0]; p1[4 * g + 1] = bb[1]; p1[4 * g + 2] = bb[2]; p1[4 * g + 3] = bb[3]; }
    const char* kb[4];
#pragma unroll
    for (int dd = 0; dd < 4; ++dd) kb[dd] = K_lds + KB * SHM_K + KSWZ(r32, (dd * 16 + hi * 8) * 2);
#pragma unroll
    for (int d0 = 0; d0 < 8; ++d0) { const char* a = kb[d0 & 3] + (d0 >> 2) * 128;
        bf16x8 b0 = *reinterpret_cast<const bf16x8*>(a);
        bf16x8 b1 = *reinterpret_cast<const bf16x8*>(a + 32 * 256);
        p0 = __builtin_amdgcn_mfma_f32_32x32x16_bf16(b0, qr[d0], p0, 0, 0, 0);
        p1 = __builtin_amdgcn_mfma_f32_32x32x16_bf16(b1, qr[d0], p1, 0, 0, 0); }
}
template <int VB, bool SK>
__device__ __forceinline__ void pv_tile(f32x16* o, int vb0, bf16x8 pa0, bf16x8 pa1, bf16x8 pa2, bf16x8 pa3, bool act) {
    if (SK && !act) return;
#define TRRD(dst, off) asm volatile("ds_read_b64_tr_b16 %0, %1 offset:%2" : "=&v"(dst) : "v"(vb0), "i"(off) : "memory")
#define PV_D0(d0) do { s16x4 l0, l1, l2, l3, h0, h1, h2, h3; constexpr int b_ = VB * SHM_V + v_rd_off(d0, 0, 0);     \
        TRRD(l0, b_); TRRD(h0, b_ + 2048); TRRD(l1, b_ + 4096); TRRD(h1, b_ + 6144); TRRD(l2, b_ + 8192); TRRD(h2, b_ + 10240); TRRD(l3, b_ + 12288); TRRD(h3, b_ + 14336); \
        asm volatile("s_waitcnt lgkmcnt(0)" ::: "memory"); SBAR();                 \
        o[d0] = __builtin_amdgcn_mfma_f32_32x32x16_bf16(pa0, (bf16x8){l0[0], l0[1], l0[2], l0[3], h0[0], h0[1], h0[2], h0[3]}, o[d0], 0, 0, 0);   \
        o[d0] = __builtin_amdgcn_mfma_f32_32x32x16_bf16(pa1, (bf16x8){l1[0], l1[1], l1[2], l1[3], h1[0], h1[1], h1[2], h1[3]}, o[d0], 0, 0, 0);   \
        o[d0] = __builtin_amdgcn_mfma_f32_32x32x16_bf16(pa2, (bf16x8){l2[0], l2[1], l2[2], l2[3], h2[0], h2[1], h2[2], h2[3]}, o[d0], 0, 0, 0);   \
        o[d0] = __builtin_amdgcn_mfma_f32_32x32x16_bf16(pa3, (bf16x8){l3[0], l3[1], l3[2], l3[3], h3[0], h3[1], h3[2], h3[3]}, o[d0], 0, 0, 0); } while (0)
    PV_D0(0); PV_D0(1); PV_D0(2); PV_D0(3);
#undef PV_D0
#undef TRRD
}

template <class TIn, class TOut> struct BlockRef { const TIn* Q; const TIn* K; const TIn* V; TOut* O; const float* CB; int P0; };
template <class TIn> struct Seam {
    bf16x8 qr[8];
    bf16x8 st_v0, st_v1, st_k0, st_k1; f32x4 sf0, sf1, sf2, sf3;
    f32x4 tq[16];
};
__device__ __forceinline__ int swa_jlo(int P0, int W) { const int lowk = P0 - W + 1; return lowk > 0 ? lowk / KVBLK : 0; }
#define ROW(p, k0, rr) ((p) + (size_t)((k0) + (rr)) * D + sc)
#define VMW() asm volatile("s_waitcnt vmcnt(0)" ::: "memory")
#define VMWN(n) asm volatile("s_waitcnt vmcnt(%0)" :: "i"(n) : "memory")
#define SLOAD_H(Kp, Vp, k0) do { S.st_v0 = load8<TIn>(ROW(Vp, k0, sr)); S.st_v1 = load8<TIn>(ROW(Vp, k0, 32 + sr));              \
                         S.st_k0 = load8<TIn>(ROW(Kp, k0, sr)); S.st_k1 = load8<TIn>(ROW(Kp, k0, 32 + sr)); } while (0)
#define SWRITE_HK(bf) do { *(bf16x8*)(K_lds + (bf) * SHM_K + kws) = S.st_k0; *(bf16x8*)(K_lds + (bf) * SHM_K + kws + 32 * 256) = S.st_k1; } while (0)
#define SWRITE_HV(bf) do { *(bf16x8*)(V_lds + (bf) * SHM_V + vst0) = S.st_v0; *(bf16x8*)(V_lds + (bf) * SHM_V + vst1) = S.st_v1; } while (0)
#define SWRITE_H(bf) do { SWRITE_HV(bf); SWRITE_HK(bf); } while (0)
#define SLOAD_F(p, k0) do { S.sf0 = *(const f32x4*)ROW(p, k0, sr); S.sf1 = *(const f32x4*)(ROW(p, k0, sr) + 4);                \
                            S.sf2 = *(const f32x4*)ROW(p, k0, 32 + sr); S.sf3 = *(const f32x4*)(ROW(p, k0, 32 + sr) + 4); } while (0)
#define SWRITE_KF(bf) do { *(bf16x8*)(K_lds + (bf) * SHM_K + kws) = pack8(S.sf0, S.sf1); *(bf16x8*)(K_lds + (bf) * SHM_K + kws + 32 * 256) = pack8(S.sf2, S.sf3); } while (0)
#define SWRITE_VF(bf) do { *(bf16x8*)(V_lds + (bf) * SHM_V + vst0) = pack8(S.sf0, S.sf1); *(bf16x8*)(V_lds + (bf) * SHM_V + vst1) = pack8(S.sf2, S.sf3); } while (0)
template <class TIn, class TOut>
__device__ __forceinline__ void causal_swa_prime(const BlockRef<TIn, TOut>& cur, int W, char* lds, Seam<TIn>& S) {
    constexpr bool F32 = same_t<TIn, float>::v;
    int tid_ = threadIdx.x; asm volatile("" : "+v"(tid_));
    const int tid = tid_, wid = __builtin_amdgcn_readfirstlane(tid >> 6), lane = tid & 63, r32 = lane & 31, hi = lane >> 5;
    const int sr = tid >> 4, sc = (tid & 15) * 8, kws = KSWZ(sr, sc * 2); char* K_lds = lds + 2 * SHM_V;
    const int kb0 = swa_jlo(cur.P0, W) * KVBLK;
    for (int d0 = 0; d0 < 8; ++d0) S.qr[d0] = load8<TIn>(cur.Q + (size_t)(wid * QBLK + r32) * D + d0 * 16 + hi * 8);
    if constexpr (F32) { SLOAD_F((const float*)cur.K, kb0); VMW(); SWRITE_KF(0); SBAR(); SLOAD_F((const float*)cur.V, kb0); }
    else { SLOAD_H(cur.K, cur.V, kb0); VMW(); SWRITE_HK(0); }
    __syncthreads();
}
template <class TIn, class TOut>
__device__ __forceinline__ void causal_swa_block(const BlockRef<TIn, TOut>& cur, const BlockRef<TIn, TOut>& nxt, int skv, int W, char* lds, Seam<TIn>& S) {
    constexpr bool F32 = same_t<TIn, float>::v;
    int tid_ = threadIdx.x; asm volatile("" : "+v"(tid_));
    const int tid = tid_, wid = __builtin_amdgcn_readfirstlane(tid >> 6), lane = tid & 63, r32 = lane & 31, hi = lane >> 5;
    const int j_lo = swa_jlo(cur.P0, W);
    int j_hi = (cur.P0 + QB - 1) / KVBLK + 1; if (j_hi > skv / KVBLK) j_hi = skv / KVBLK;
    const int NT = j_hi - j_lo;
    const int kbn = swa_jlo(nxt.P0, W) * KVBLK;
    const int qlo = cur.P0 + wid * QBLK, qm = qlo + r32 - 4 * hi;
    char* V_lds = lds; char* K_lds = lds + 2 * SHM_V;
    float* ws = (float*)(lds + 2 * SHM_V + 2 * SHM_K) + wid * 64; float* li_l = ws, * al_l = ws + 32;
    float m_reg = -1e30f, l_reg = 0; f32x16 o[4] = {};
    const ALAS float* cbl = (const ALAS float*)(lds + 2 * SHM_V + 2 * SHM_K + NW * 64 * 4);
    { const int nk4 = j_hi * (KVBLK / 4); for (int i = tid; i < nk4; i += 64 * NW) ((ALAS f32x4*)cbl)[i] = ((const f32x4*)cur.CB)[i]; __syncthreads(); }
    const int sr = tid >> 4, sc = (tid & 15) * 8, vst0 = v_st(sr, sc), vst1 = v_st(32 + sr, sc), kws = KSWZ(sr, sc * 2);
    const int vb0 = (int)(uintptr_t)V_lds + v_rd_base(lane);
    const TIn* Kh = cur.K; const TIn* Vh = cur.V;
#define RESC(a) do { if (__any((a) < 1.f)) { if (hi == 0) al_l[r32] = (a); asm volatile("s_waitcnt lgkmcnt(0)" ::: "memory");              \
                     for (int d_ = 0; d_ < 4; ++d_) for (int r = 0; r < 16; ++r) o[d_][r] *= al_l[crow(r, hi)]; } } while (0)
#define KBASE(t) ((j_lo + (t)) * KVBLK)
#define CBT(t) (cbl + KBASE(t) + 4 * hi)
#define ACT(t) (KBASE(t) <= qlo + QBLK - 1 && KBASE(t) + KVBLK - 1 >= qlo - W + 1)
#define MASKT(P0_, P1_, t) do { const int kb_ = KBASE(t); if ((!SK || ACT(t)) && (kb_ + KVBLK - 1 > qlo || kb_ <= qlo + QBLK - 1 - W)) mask_tile(P0_, P1_, qm - kb_, (unsigned)W); } while (0)
    constexpr int NQL = F32 ? 16 : 8;
    constexpr bool SK = WSKIP && !F32;
#define SEAM_K0() do { VMWN(NQL); if constexpr (F32) { SWRITE_KF(0); SBAR(); SLOAD_F((const float*)nxt.V, kbn); } else { SWRITE_HK(0); } SBAR(); } while (0)
    f32x16 pA0, pA1, pB0, pB1; float mnA, mnB, alA, alB; bf16x8 pa0, pa1, pa2, pa3;
    if constexpr (F32) { VMW(); SWRITE_VF(0); SBAR(); } else { SWRITE_HV(0); SBAR(); }
    if (NT > 1) { if constexpr (F32) SLOAD_F((const float*)Kh, KBASE(1)); else SLOAD_H(Kh, Vh, KBASE(1)); }
    SBAR(); qkt<0, SK>(pA0, pA1, K_lds, r32, hi, S.qr, ACT(0), CBT(0));
    if constexpr (F32) { if (NT > 1) { VMW(); SWRITE_KF(1); SBAR(); SLOAD_F((const float*)Vh, KBASE(1)); } }
    MASKT(pA0, pA1, 0); partialSM(pA0, pA1, m_reg, mnA, alA);
    if (NT > 1) { VMW(); if constexpr (F32) { SWRITE_VF(1); SBAR(); if (NT > 2) SLOAD_F((const float*)Kh, KBASE(2)); } else SWRITE_H(1); }
    __syncthreads();
#define HALF_STEP(PX0, PX1, mnX, alX, PY0, PY1, alY, t, KB, VB, SB) do {                                                      \
        SBAR(); qkt<KB, SK>(PX0, PX1, K_lds, r32, hi, S.qr, ACT(t), CBT(t));                                             \
        finishSM(PY0, PY1, alY, l_reg, pa0, pa1, pa2, pa3); SBAR();                                                           \
        if ((t) + 1 < NT) { if constexpr (F32) { VMW(); SWRITE_KF(SB); SBAR(); SLOAD_F((const float*)Vh, KBASE((t) + 1)); }  \
                            else { SLOAD_H(Kh, Vh, KBASE((t) + 1)); } SBAR(); }                                               \
        pv_tile<VB, SK>(o, vb0, pa0, pa1, pa2, pa3, ACT((t) - 1)); MASKT(PX0, PX1, (t)); partialSM(PX0, PX1, m_reg, mnX, alX);                                        \
        __syncthreads();                                                                                                      \
        if ((t) + 1 < NT) { VMW(); if constexpr (F32) { SWRITE_VF(SB); SBAR(); if ((t) + 2 < NT) SLOAD_F((const float*)Kh, KBASE((t) + 2)); } \
                            else { SWRITE_H(SB); } }                                                                          \
        RESC(alX); __syncthreads(); } while (0)
    for (int t = 1; t + 1 < NT; t += 2) {
        HALF_STEP(pB0, pB1, mnB, alB, pA0, pA1, alA, t, 1, 0, 0);
        HALF_STEP(pA0, pA1, mnA, alA, pB0, pB1, alB, t + 1, 0, 1, 1);
    }
    const bool even = (NT & 1) == 0;
    if (even) { SBAR(); qkt<1, SK>(pB0, pB1, K_lds, r32, hi, S.qr, ACT(NT - 1), CBT(NT - 1)); SBAR(); }
#define QROW(e) (nxt.Q + (size_t)(wid * QBLK + r32) * D + ((e) >> 1) * 16 + hi * 8 + ((e) & 1) * 4)
    if constexpr (F32) { SLOAD_F((const float*)nxt.K, kbn); SBAR();
#pragma unroll
        for (int e = 0; e < 8; ++e) S.tq[e] = *(const f32x4*)QROW(e); }
    else { SLOAD_H(nxt.K, nxt.V, kbn); SBAR();
#pragma unroll
        for (int d0 = 0; d0 < 8; ++d0) S.qr[d0] = load8<TIn>(nxt.Q + (size_t)(wid * QBLK + r32) * D + d0 * 16 + hi * 8); }
    SBAR();
    finishSM(pA0, pA1, alA, l_reg, pa0, pa1, pa2, pa3); SBAR();
    if constexpr (F32) {
#pragma unroll
        for (int e = 8; e < 16; ++e) S.tq[e] = *(const f32x4*)QROW(e); SBAR(); }
#undef QROW
    pv_tile<0, SK>(o, vb0, pa0, pa1, pa2, pa3, ACT(even ? NT - 2 : NT - 1));
    if (even) { MASKT(pB0, pB1, NT - 1); partialSM(pB0, pB1, m_reg, mnB, alB); __syncthreads(); RESC(alB);
        finishSM(pB0, pB1, alB, l_reg, pa0, pa1, pa2, pa3); SBAR(); pv_tile<1, SK>(o, vb0, pa0, pa1, pa2, pa3, ACT(NT - 1)); }
    SBAR(); SEAM_K0();
    if (hi == 0) li_l[r32] = l_reg; asm volatile("s_waitcnt lgkmcnt(0)" ::: "memory");
    float rli[16];
#pragma unroll
    for (int r = 0; r < 16; ++r) rli[r] = __builtin_amdgcn_rcpf(li_l[crow(r, hi)]);
    TOut* Ow = cur.O + (size_t)(wid * QBLK) * OSTR;
#pragma unroll
    for (int r = 0; r < 16; ++r) { const int orow = crow(r, hi);
#pragma unroll
        for (int d0 = 0; d0 < 4; ++d0) { const float v = o[d0][r] * rli[r];
            if constexpr (same_t<TOut, float>::v) { Ow[(size_t)orow * OSTR + d0 * 32 + r32] = v; }
            else { const float vn = __shfl_xor(v, 1);
                   if ((r32 & 1) == 0) *(unsigned*)(Ow + (size_t)orow * OSTR + d0 * 32 + r32) = cvtpk(v, vn); } } }
    if constexpr (F32) {
#pragma unroll
        for (int d0 = 0; d0 < 8; ++d0) S.qr[d0] = pack8(S.tq[2 * d0], S.tq[2 * d0 + 1]); }
    __syncthreads();
#undef RESC
#undef KBASE
#undef CBT
#undef ACT
#undef MASKT
#undef SEAM_K0
#undef HALF_STEP
}
#undef ROW
#undef VMW
#undef VMWN
#undef SLOAD_H
#undef SWRITE_HK
#undef SWRITE_HV
#undef SWRITE_H
#undef SLOAD_F
#undef SWRITE_KF
#undef SWRITE_VF

#undef KSWZ
#undef SBAR
}

#define LAS __attribute__((address_space(3)))
typedef unsigned short bf16;
typedef float f32x4 __attribute__((ext_vector_type(4)));
typedef unsigned u32x4 __attribute__((ext_vector_type(4)));
typedef unsigned u32x2 __attribute__((ext_vector_type(2)));
constexpr int NWAVES = 8, NTHR = 512;
constexpr int DM = 1024, FF = 2816, TOK = 16384, MT = 16640, NMETA = 16, SEQ = 8192, NH = 8, KVPOS = 8256;
constexpr float LN_EPS = 1e-5f;
constexpr size_t MiB = 1u << 20;
constexpr size_t UPSZ = (size_t)2 * FF * DM, DNSZ = (size_t)DM * FF, SQ = (size_t)DM * DM;
constexpr size_t W_UP10 = 0, W_DN10 = W_UP10 + UPSZ, W_UP20 = W_DN10 + DNSZ, W_DN20 = W_UP20 + UPSZ, W_CIN = W_DN20 + DNSZ, W_COUT = W_CIN + 3 * SQ, W_KV = W_COUT + SQ,
                 W_UP11 = W_KV + 2 * SQ, W_DN11 = W_UP11 + UPSZ, W_UP21 = W_DN11 + DNSZ, W_DN21 = W_UP21 + UPSZ, W_Q = W_DN21 + DNSZ, W_O = W_Q + SQ, W_END = W_O + SQ;
constexpr size_t WS_W = 1 * MiB, WS_HB = 84 * MiB, WS_BIG = 117 * MiB, WS_V = 207 * MiB, WS_XM = 240 * MiB, WS_FLOG = 241 * MiB, WS_CB = 242 * MiB, WS_END = 243 * MiB;
static_assert(WS_W + W_END * 2 <= WS_HB && WS_HB + (size_t)MT * DM * 2 <= WS_BIG && WS_BIG + (size_t)MT * FF * 2 <= WS_V && WS_V + (size_t)2 * NH * KVPOS * 128 * 2 <= WS_XM, "ws map");
static_assert((size_t)2 * NH * KVPOS * 128 * 2 <= W_CIN * 2, "K overlay fits in the dead layer-0 FFN weights");
static_assert((size_t)(MT + NMETA) * NH * 4 <= MiB && (size_t)2 * NH * KVPOS * 4 <= MiB && (size_t)256 * DM * 4 <= MiB, "small buffers");
constexpr int LDS_PHASE = 131072, LDS_TOTAL = LDS_PHASE + 256;
static_assert(att::LDS_BYTES <= LDS_PHASE && pg8::STAGE_BYTES <= LDS_PHASE, "LDS");

struct Args { const float* in[17]; float* out; unsigned char* ws; };

__device__ __forceinline__ unsigned pk2(float lo, float hi) { return pg8::cvt_pk_bf16(lo, hi); }
__device__ __forceinline__ float wave_sum(float v) {
#pragma unroll
    for (int o = 1; o < 64; o <<= 1) v += __shfl_xor(v, o);
    return v;
}
__device__ __forceinline__ void tr_item(const float* W, int ldw, int K, int k0, int n0, bf16* WTrow0, LAS float* scr, int lane) {
#pragma unroll 8
    for (int i = 0; i < 32; ++i) { const int kk = 2 * i + (lane >> 5); scr[kk * 33 + (lane & 31)] = W[(size_t)(k0 + kk) * ldw + n0 + (lane & 31)]; }
    asm volatile("s_waitcnt lgkmcnt(0)" ::: "memory");
    const int c = lane & 7;
#pragma unroll
    for (int j = 0; j < 4; ++j) { const int n = (lane >> 3) + 8 * j; const LAS float* s = scr + (8 * c) * 33 + n;
        u32x4 o; o.x = pk2(s[0 * 33], s[1 * 33]); o.y = pk2(s[2 * 33], s[3 * 33]); o.z = pk2(s[4 * 33], s[5 * 33]); o.w = pk2(s[6 * 33], s[7 * 33]);
        *(u32x4*)(WTrow0 + (size_t)n * K + k0 + 8 * c) = o; }
    asm volatile("s_waitcnt lgkmcnt(0)" ::: "memory");
}
__device__ __forceinline__ int drow(int kind, int n0) {
    if (kind == 0) return n0;
    if (kind == 1) return (n0 >> 7) * 256 + (n0 & 127);
    if (kind == 2) return (n0 >> 7) * 256 + 128 + (n0 & 127);
    if (n0 < 1024) return 2048 + n0;
    if (n0 < 2048) { const int j = n0 - 1024; return (j >> 7) * 256 + (j & 127); }
    { const int j = n0 - 2048; return (j >> 7) * 256 + 128 + (j & 127); }
}
#define TR_TRY(Wp, ldw_, K_, N_, dst_, kind_) { const int cnt_ = ((K_) / 64) * ((N_) / 32); if (r < cnt_) { const int nblk_ = (N_) / 32, kb_ = r / nblk_, n0_ = (r % nblk_) * 32; \
        tr_item((Wp), (ldw_), (K_), kb_ * 64, n0_, (dst_) + (size_t)drow((kind_), n0_) * (K_), scr, lane); continue; } r -= cnt_; }
__device__ __forceinline__ void p0_prologue(const Args& a, LAS unsigned char* lds, int vcu, int G) {
    int tid_ = threadIdx.x; asm volatile("" : "+v"(tid_)); const int lane = tid_ & 63, wave = __builtin_amdgcn_readfirstlane(tid_ >> 6); (void)lane; (void)wave;
    const int gw = vcu * NWAVES + wave, NGW = G * NWAVES, gtid = blockIdx.x * NTHR + tid_, NGT = G * NTHR;
    bf16* WT = (bf16*)(a.ws + WS_W);
    LAS float* scr = (LAS float*)(lds + wave * 16384);
    constexpr int I_UP = (DM / 64) * (FF / 32), I_DN = (FF / 64) * (DM / 32), I_SQ = (DM / 64) * (DM / 32);
    constexpr int NITEMS = 8 * I_UP + 4 * I_DN + 3 * I_SQ + 2 * I_SQ + 3 * I_SQ;
    for (int it = gw; it < NITEMS; it += NGW) {
        int r = it;
        TR_TRY(a.in[2], FF, DM, FF, WT + W_UP10, 1) TR_TRY(a.in[3], FF, DM, FF, WT + W_UP10, 2) TR_TRY(a.in[4], DM, FF, DM, WT + W_DN10, 0)
        TR_TRY(a.in[5], FF, DM, FF, WT + W_UP20, 1) TR_TRY(a.in[6], FF, DM, FF, WT + W_UP20, 2) TR_TRY(a.in[7], DM, FF, DM, WT + W_DN20, 0)
        TR_TRY(a.in[10], 3 * DM, DM, 3 * DM, WT + W_CIN, 3) TR_TRY(a.in[12], DM, DM, DM, WT + W_COUT, 0) TR_TRY(a.in[13], 2 * DM + NH, DM, 2 * DM, WT + W_KV, 0)
        TR_TRY(a.in[2] + (size_t)DM * FF, FF, DM, FF, WT + W_UP11, 1) TR_TRY(a.in[3] + (size_t)DM * FF, FF, DM, FF, WT + W_UP11, 2) TR_TRY(a.in[4] + (size_t)DM * FF, DM, FF, DM, WT + W_DN11, 0)
        TR_TRY(a.in[5] + (size_t)DM * FF, FF, DM, FF, WT + W_UP21, 1) TR_TRY(a.in[6] + (size_t)DM * FF, FF, DM, FF, WT + W_UP21, 2) TR_TRY(a.in[7] + (size_t)DM * FF, DM, FF, DM, WT + W_DN21, 0)
        TR_TRY(a.in[15], DM, DM, DM, WT + W_Q, 0) TR_TRY(a.in[16], DM, DM, DM, WT + W_O, 0)
    }
    bf16* hb = (bf16*)(a.ws + WS_HB); const float* x = a.in[0];
    for (int idx = gtid; idx < TOK * 128; idx += NGT) { const f32x4 v0 = *(const f32x4*)(x + (size_t)idx * 8), v1 = *(const f32x4*)(x + (size_t)idx * 8 + 4);
        *(u32x4*)(hb + (size_t)idx * 8) = pg8::pack8(v0, v1); }
    float* Xm = (float*)(a.ws + WS_XM); const float* meta = a.in[1];
    for (int idx = gtid; idx < 256 * 128; idx += NGT) { const int row = idx >> 7; f32x4 v0 = {0.f, 0.f, 0.f, 0.f}, v1 = v0;
        if (row < NMETA) { v0 = *(const f32x4*)(meta + (size_t)idx * 8); v1 = *(const f32x4*)(meta + (size_t)idx * 8 + 4); }
        *(f32x4*)(Xm + (size_t)idx * 8) = v0; *(f32x4*)(Xm + (size_t)idx * 8 + 4) = v1; *(u32x4*)(hb + (size_t)TOK * DM + (size_t)idx * 8) = pg8::pack8(v0, v1); }
    bf16* Vb = (bf16*)(a.ws + WS_V);
    for (int idx = gtid; idx < 16 * 48 * 16; idx += NGT) { const int bh = idx / (48 * 16), rem = idx % (48 * 16);
        *(u32x4*)(Vb + ((size_t)bh * KVPOS + 8208) * 128 + (size_t)rem * 8) = (u32x4){0u, 0u, 0u, 0u}; }
}
template <bool HB, bool FLOG>
__device__ __forceinline__ void ln_phase(const Args& a, LAS unsigned char* lds, int nrows, const float* gain, const float* beta, int vcu, int G) {
    int tid_ = threadIdx.x; asm volatile("" : "+v"(tid_)); const int lane = tid_ & 63, wave = __builtin_amdgcn_readfirstlane(tid_ >> 6); (void)lane; (void)wave;
    const int gw = vcu * NWAVES + wave, NGW = G * NWAVES;
    float* Xt = a.out; float* Xm = (float*)(a.ws + WS_XM); bf16* hb = (bf16*)(a.ws + WS_HB); float* flog = (float*)(a.ws + WS_FLOG);
    LAS float* wfl = (LAS float*)lds;
    if (FLOG) { const float* kvw = a.in[13];
        for (int k = tid_; k < DM; k += NTHR) { const f32x4 w0 = *(const f32x4*)(kvw + (size_t)k * (2 * DM + NH) + 2 * DM), w1 = *(const f32x4*)(kvw + (size_t)k * (2 * DM + NH) + 2 * DM + 4);
            wfl[0 * DM + k] = w0[0]; wfl[1 * DM + k] = w0[1]; wfl[2 * DM + k] = w0[2]; wfl[3 * DM + k] = w0[3]; wfl[4 * DM + k] = w1[0]; wfl[5 * DM + k] = w1[1]; wfl[6 * DM + k] = w1[2]; wfl[7 * DM + k] = w1[3]; }
        __syncthreads(); }
    f32x4 g[4], bt[4];
#pragma unroll
    for (int j = 0; j < 4; ++j) { g[j] = *(const f32x4*)(gain + 4 * lane + 256 * j); bt[j] = *(const f32x4*)(beta + 4 * lane + 256 * j); }
    for (int row = gw; row < nrows; row += NGW) {
        float* xr = (row < TOK) ? Xt + (size_t)row * DM : Xm + (size_t)(row - TOK) * DM;
        f32x4 v[4]; float s = 0.f;
#pragma unroll
        for (int j = 0; j < 4; ++j) { v[j] = *(const f32x4*)(xr + 4 * lane + 256 * j); s += (v[j][0] + v[j][1]) + (v[j][2] + v[j][3]); }
        const float mean = wave_sum(s) * (1.f / DM); float s2 = 0.f;
#pragma unroll
        for (int j = 0; j < 4; ++j) { v[j] = v[j] - mean; s2 += (v[j][0] * v[j][0] + v[j][1] * v[j][1]) + (v[j][2] * v[j][2] + v[j][3] * v[j][3]); }
        const float rstd = 1.f / sqrtf(wave_sum(s2) * (1.f / DM) + LN_EPS);
#pragma unroll
        for (int j = 0; j < 4; ++j) { v[j] = v[j] * rstd * g[j] + bt[j]; *(f32x4*)(xr + 4 * lane + 256 * j) = v[j];
            if (HB) { u32x2 w; w.x = pk2(v[j][0], v[j][1]); w.y = pk2(v[j][2], v[j][3]); *(u32x2*)(hb + (size_t)row * DM + 4 * lane + 256 * j) = w; } }
        if (FLOG) { float myv = 0.f;
#pragma unroll
            for (int h = 0; h < NH; ++h) { float d = 0.f;
#pragma unroll
                for (int j = 0; j < 4; ++j) { const f32x4 w = *(const LAS f32x4*)(wfl + h * DM + 4 * lane + 256 * j); d += (v[j][0] * w[0] + v[j][1] * w[1]) + (v[j][2] * w[2] + v[j][3] * w[3]); }
                d = wave_sum(d); if (lane == h) myv = d; }
            if (lane < NH) { const float z = myv + a.in[14][lane]; const float ls = fminf(z, 0.f) - log1pf(expf(-fabsf(z))); flog[(size_t)row * NH + lane] = ls; } }
    }
    if (FLOG) __syncthreads();
}
__device__ __forceinline__ f32x4 bflo(u32x4 w, int half) { const unsigned a = half ? w.z : w.x, b = half ? w.w : w.y;
    return (f32x4){__uint_as_float(a << 16), __uint_as_float(a & 0xffff0000u), __uint_as_float(b << 16), __uint_as_float(b & 0xffff0000u)}; }
__device__ __forceinline__ void conv_phase(const Args& a, int G) {
    int tid_ = threadIdx.x; asm volatile("" : "+v"(tid_)); const int lane = tid_ & 63, wave = __builtin_amdgcn_readfirstlane(tid_ >> 6); (void)lane; (void)wave;
    const int gtid = blockIdx.x * NTHR + tid_, NGT = G * NTHR;
    bf16* ub = (bf16*)(a.ws + WS_BIG); bf16* bb = ub + (size_t)MT * DM; const float* cw = a.in[11];
    constexpr int NGRP = TOK / 8 + 2;
    for (int item = gtid; item < NGRP * 128; item += NGT) { const int ch = item & 127, rg = item >> 7;
        int b, p0; if (rg < TOK / 8) { b = rg >> 10; p0 = 16 + (rg & 1023) * 8; } else { b = 0; p0 = (rg - TOK / 8) * 8; }
        const f32x4 w0a = *(const f32x4*)(cw + ch * 8), w0b = *(const f32x4*)(cw + ch * 8 + 4), w1a = *(const f32x4*)(cw + DM + ch * 8), w1b = *(const f32x4*)(cw + DM + ch * 8 + 4),
                    w2a = *(const f32x4*)(cw + 2 * DM + ch * 8), w2b = *(const f32x4*)(cw + 2 * DM + ch * 8 + 4);
        u32x4 um2 = {0u, 0u, 0u, 0u}, um1 = um2;
#define UROW(p) ((p) < 16 ? (size_t)(TOK + (p)) : (size_t)(b * SEQ + (p) - 16))
        if (p0 - 2 >= 0) um2 = *(const u32x4*)(ub + UROW(p0 - 2) * DM + ch * 8);
        if (p0 - 1 >= 0) um1 = *(const u32x4*)(ub + UROW(p0 - 1) * DM + ch * 8);
#pragma unroll
        for (int i = 0; i < 8; ++i) { const size_t ro = UROW(p0 + i) * DM + ch * 8;
            const u32x4 u0 = *(const u32x4*)(ub + ro), bg = *(const u32x4*)(bb + ro);
            const f32x4 ya = w0a * bflo(um2, 0) + w1a * bflo(um1, 0) + w2a * bflo(u0, 0), yb = w0b * bflo(um2, 1) + w1b * bflo(um1, 1) + w2b * bflo(u0, 1);
            *(u32x4*)(bb + ro) = pg8::pack8(bflo(bg, 0) * ya, bflo(bg, 1) * yb);
            um2 = um1; um1 = u0; }
#undef UROW
    }
}
__device__ __forceinline__ void scan_bh(const Args& a, LAS unsigned char* lds, int bh) {
    const float* flog = (const float*)(a.ws + WS_FLOG); float* cb = (float*)(a.ws + WS_CB) + (size_t)bh * KVPOS;
    int tid_ = threadIdx.x; asm volatile("" : "+v"(tid_));
    const int b = bh >> 3, h = bh & 7, tid = tid_, lane = tid & 63, wave = tid >> 6; LAS float* wtot = (LAS float*)lds;
    constexpr int PER = 17; float v[PER]; float s = 0.f;
#pragma unroll
    for (int i = 0; i < PER; ++i) { const int p = tid * PER + i; float x = 0.f;
        if (p < SEQ + NMETA) { const size_t row = p < 16 ? (size_t)(TOK + p) : (size_t)(b * SEQ + p - 16); x = flog[row * NH + h]; }
        s += x; v[i] = s; }
    float incl = s;
#pragma unroll
    for (int o = 1; o < 64; o <<= 1) { const float t = __shfl_up(incl, o); if (lane >= o) incl += t; }
    if (lane == 63) wtot[wave] = incl;
    __syncthreads();
    float base = incl - s;
    for (int w = 0; w < wave; ++w) base += wtot[w];
    const float NS = -11.313708498984761f;
#pragma unroll
    for (int i = 0; i < PER; ++i) { const int p = tid * PER + i; if (p < KVPOS) cb[p] = (p < SEQ + NMETA) ? NS * (base + v[i]) : 0.f; }
    __syncthreads();
}
typedef short bf16x8_t __attribute__((ext_vector_type(8)));
enum { MK_SWIGLU = 0, MK_RESID = 1, MK_CONVIN = 2, MK_KV = 3 };
template <int KIND>
__device__ __forceinline__ void meta_phase(const Args& a, LAS unsigned char* lds, const bf16* A, int K, const bf16* Wt, int nunits, float scale, int G) {
    int tid_ = threadIdx.x; asm volatile("" : "+v"(tid_)); const int lane = tid_ & 63, wave = __builtin_amdgcn_readfirstlane(tid_ >> 6);
    const int m = lane & 15, kq = lane >> 4, kper = K / 8, k0 = wave * kper;
    LAS f32x4* red = (LAS f32x4*)lds;
    for (int u = G - 1 - (int)blockIdx.x; u < nunits; u += G) {
        constexpr bool DUAL_ALWAYS = (KIND == MK_SWIGLU);
        const bool dual = DUAL_ALWAYS || (KIND == MK_CONVIN && u < 64);
        int r0;
        if (KIND == MK_SWIGLU) { const int j0 = 16 * u; r0 = (j0 >> 7) * 256 + (j0 & 127); }
        else if (KIND == MK_CONVIN) { if (u < 64) { const int j0 = 16 * u; r0 = (j0 >> 7) * 256 + (j0 & 127); } else r0 = 2048 + 16 * (u - 64); }
        else r0 = 16 * u;
        const bf16* ap = A + (size_t)m * K + k0 + 8 * kq; const bf16* b0p = Wt + (size_t)(r0 + m) * K + k0 + 8 * kq; const bf16* b1p = b0p + (size_t)128 * K;
        f32x4 acc0 = {0.f, 0.f, 0.f, 0.f}, acc1 = acc0;
#pragma unroll 4
        for (int k = 0; k < kper; k += 32) { const bf16x8_t av = *(const bf16x8_t*)(ap + k), b0 = *(const bf16x8_t*)(b0p + k);
            acc0 = __builtin_amdgcn_mfma_f32_16x16x32_bf16(b0, av, acc0, 0, 0, 0);
            if (dual) { const bf16x8_t b1 = *(const bf16x8_t*)(b1p + k); acc1 = __builtin_amdgcn_mfma_f32_16x16x32_bf16(b1, av, acc1, 0, 0, 0); } }
        red[(wave * 2 + 0) * 64 + lane] = acc0; red[(wave * 2 + 1) * 64 + lane] = acc1;
        __syncthreads();
        if (wave == 0) {
            acc0 = red[lane]; acc1 = red[64 + lane];
#pragma unroll
            for (int w = 1; w < 8; ++w) { acc0 += red[(w * 2) * 64 + lane]; acc1 += red[(w * 2 + 1) * 64 + lane]; }
            const int fq = kq;
            if (KIND == MK_SWIGLU) { const f32x4 v = pg8::silu_mul4(acc0, acc1); u32x2 w; w.x = pk2(v[0], v[1]); w.y = pk2(v[2], v[3]);
                *(u32x2*)((bf16*)(a.ws + WS_BIG) + (size_t)(TOK + m) * FF + 16 * u + 4 * fq) = w; }
            else if (KIND == MK_RESID) { float* xp = (float*)(a.ws + WS_XM) + (size_t)m * DM + 16 * u + 4 * fq; const f32x4 x = *(const f32x4*)xp; *(f32x4*)xp = x * 1.4142135623730951f + acc0 * scale; }
            else if (KIND == MK_CONVIN) { bf16* ub = (bf16*)(a.ws + WS_BIG); bf16* bb = ub + (size_t)MT * DM;
                if (u < 64) { const f32x4 v = acc0 * acc1; u32x2 w; w.x = pk2(v[0], v[1]); w.y = pk2(v[2], v[3]); *(u32x2*)(ub + (size_t)(TOK + m) * DM + 16 * u + 4 * fq) = w; }
                else { u32x2 w; w.x = pk2(acc0[0], acc0[1]); w.y = pk2(acc0[2], acc0[3]); *(u32x2*)(bb + (size_t)(TOK + m) * DM + 16 * (u - 64) + 4 * fq) = w; } }
            else { const int n0 = 16 * u, col = n0 & 1023, h = col >> 7, d = (col & 127) + 4 * fq; bf16* base = (n0 < 1024) ? (bf16*)(a.ws + WS_W) : (bf16*)(a.ws + WS_V);
                u32x2 w; w.x = pk2(acc0[0], acc0[1]); w.y = pk2(acc0[2], acc0[3]);
                *(u32x2*)(base + ((size_t)(0 * NH + h) * KVPOS + m) * 128 + d) = w; *(u32x2*)(base + ((size_t)(1 * NH + h) * KVPOS + m) * 128 + d) = w; }
        }
        __syncthreads();
    }
}
#define XB_TMO      128
#define XB_XCNT(j)  (256  + 64 * (j))
#define XB_XSUB(j)  (1280 + 64 * (j))
#define XB_XGEN(j)  (2304 + 64 * (j))
#define XB_TOP      3328
#define XB_TOPGEN   3392
#define XCD_BAR_WORDS 3456
#define XB_SPIN_CAP (1u << 18)

__device__ __forceinline__ unsigned xb_ld(unsigned* p)              { return __hip_atomic_load(p, __ATOMIC_RELAXED, __HIP_MEMORY_SCOPE_AGENT); }
__device__ __forceinline__ unsigned xb_add(unsigned* p, unsigned v) { return __hip_atomic_fetch_add(p, v, __ATOMIC_RELAXED, __HIP_MEMORY_SCOPE_AGENT); }
__device__ __forceinline__ unsigned xb_xcc_id() { return (unsigned)__builtin_amdgcn_s_getreg((3 << 11) | 20) & 0xFu; }
#define XB_SPIN(cond, bar) do { unsigned _sp = 0; while (cond) { __builtin_amdgcn_s_sleep(1); \
    if ((++_sp & 255u) == 0u) { if (xb_ld(&(bar)[XB_TMO])) break; if (_sp > XB_SPIN_CAP) { atomicAdd(&(bar)[XB_TMO], 1u); break; } } } } while (0)

struct XcdBarrier {
    unsigned* bar; unsigned x;
    volatile LAS unsigned* st;
};

__device__ __forceinline__ XcdBarrier xcd_barrier_post(unsigned* bar, volatile LAS unsigned* st) {
    XcdBarrier b; b.bar = bar; b.x = xb_xcc_id(); b.st = st;
    if (threadIdx.x == 0) (void)xb_add(&bar[XB_XCNT(b.x)], 1u);
    return b;
}
__device__ __forceinline__ void xcd_barrier_complete(unsigned* bar, unsigned x, unsigned& nloc, unsigned& nx) {
    const unsigned G = gridDim.x * gridDim.y * gridDim.z;
    unsigned sum, cnt, mine, sp = 0u;
    for (;;) {
        sum = 0u; cnt = 0u; mine = 0u;
#pragma unroll
        for (unsigned j = 0; j < 16; ++j) { const unsigned c = xb_ld(&bar[XB_XCNT(j)]); sum += c; cnt += (c > 0u) ? 1u : 0u; mine = (j == x) ? c : mine; }
        if (sum == G) break;
        __builtin_amdgcn_s_sleep(1);
        if ((++sp & 255u) == 0u) { if (xb_ld(&bar[XB_TMO])) break; if (sp > XB_SPIN_CAP) { atomicAdd(&bar[XB_TMO], 1u); break; } }
    }
    nloc = mine > 0u ? mine : 1u; nx = cnt > 0u ? cnt : 1u;
}

__device__ __forceinline__ void xcd_barrier(const XcdBarrier& b) {
    asm volatile("s_waitcnt vmcnt(0)" ::: "memory");
    __syncthreads();
    if (threadIdx.x == 0) {
        unsigned* bar = b.bar;
        __builtin_amdgcn_s_waitcnt(0);
        unsigned nloc = b.st[0], nx = b.st[1];
        if (nloc == 0u) { xcd_barrier_complete(bar, b.x, nloc, nx); b.st[0] = nloc; b.st[1] = nx; }
        const unsigned old = xb_add(&bar[XB_XSUB(b.x)], 1u);
        const unsigned gen = old / nloc;
        if (old + 1u == (gen + 1u) * nloc) {
            __builtin_amdgcn_fence(__ATOMIC_RELEASE, "agent");
            asm volatile("s_waitcnt vmcnt(0)" ::: "memory");
            const unsigned og = xb_add(&bar[XB_TOP], 1u);
            const unsigned tg = og / nx;
            if (og + 1u == (tg + 1u) * nx) xb_add(&bar[XB_TOPGEN], 1u);
            else XB_SPIN(xb_ld(&bar[XB_TOPGEN]) == tg, bar);
            __builtin_amdgcn_fence(__ATOMIC_ACQUIRE, "agent");
            xb_add(&bar[XB_XGEN(b.x)], 1u);
            asm volatile("s_waitcnt vmcnt(0)" ::: "memory");
        } else {
            XB_SPIN(xb_ld(&bar[XB_XGEN(b.x)]) == gen, bar);
            __builtin_amdgcn_fence(__ATOMIC_ACQUIRE, "agent");
            asm volatile("s_waitcnt vmcnt(0)" ::: "memory");
        }
    }
    __syncthreads();
}

typedef att::BlockRef<att::bf16, att::bf16> ABlock;
__device__ __forceinline__ ABlock att_ref(const Args& a, int L, int pass) {
    const int bh = L >> 4, x = L & 15, qb = pass ? 31 - x : x, b = bh >> 3, h = bh & 7;
    const att::bf16* Q = (const att::bf16*)(a.ws + WS_BIG); att::bf16* O = (att::bf16*)(a.ws + WS_BIG + 32 * MiB);
    const att::bf16* K = (const att::bf16*)(a.ws + WS_W); const att::bf16* V = (const att::bf16*)(a.ws + WS_V);
    ABlock r; r.Q = Q + ((size_t)bh * SEQ + (size_t)qb * 256) * 128; r.K = K + (size_t)bh * KVPOS * 128; r.V = V + (size_t)bh * KVPOS * 128;
    r.O = O + ((size_t)b * SEQ + (size_t)qb * 256) * DM + h * 128; r.CB = (const float*)(a.ws + WS_CB) + (size_t)bh * KVPOS; r.P0 = NMETA + qb * 256;
    return r;
}
__device__ __forceinline__ void attn_phase(const Args& a, char* lds, int vcu, int G) {
    constexpr int total = 256, W = 1 << 30;
    int L = vcu; if (L >= total) return;
    int pass = 0; ABlock cur = att_ref(a, L, 0);
    att::Seam<att::bf16> S;
    att::causal_swa_prime<att::bf16, att::bf16>(cur, W, lds, S);
    for (;;) {
        const bool more_pass = pass == 0, more_item = L + G < total, last = !more_pass && !more_item;
        int passn = pass + 1, Ln = L;
        if (!more_pass) { passn = 0; Ln = more_item ? L + G : L; }
        const ABlock nxt = last ? cur : att_ref(a, Ln, passn);
        att::causal_swa_block<att::bf16, att::bf16>(cur, nxt, KVPOS, W, lds, S);
        if (last) break;
        cur = nxt; pass = passn; L = Ln;
    }
}

__global__ void __launch_bounds__(NTHR, 2) yoco_fwd(Args a) {
    extern __shared__ __attribute__((aligned(16))) unsigned char lds_raw[];
    cg::grid_group grid = cg::this_grid();
    LAS unsigned char* lds = (LAS unsigned char*)lds_raw;
    if (threadIdx.x < 64) ((LAS unsigned*)(lds + LDS_PHASE))[threadIdx.x] = 0u;
    __syncthreads();
    XcdBarrier bar = xcd_barrier_post((unsigned*)a.ws, (volatile LAS unsigned*)(lds + LDS_PHASE));
    const int G = gridDim.x, bx = blockIdx.x, vcu = (G % 8 == 0) ? (bx % 8) * (G / 8) + bx / 8 : bx;
    bf16* WT = (bf16*)(a.ws + WS_W); bf16* hb = (bf16*)(a.ws + WS_HB); bf16* big = (bf16*)(a.ws + WS_BIG);
    float* Xm = (float*)(a.ws + WS_XM);
    const float* lng = a.in[8]; const float* lnb = a.in[9];
#define GEMM(EpiT, E_, A_, B_, M_, N_, K_) do { pg8::Gemm g_{(A_), (B_), (M_), (N_), (K_)}; pg8::StaticOrder S_; S_.init((M_), (N_), G, bx); \
        pg8::gemm_phase<EpiT, pg8::StaticOrder, true, true>(lds, g_, S_, (E_)); } while (0)

    p0_prologue(a, lds, vcu, G);
    grid.sync();
    meta_phase<MK_SWIGLU>(a, lds, hb + (size_t)TOK * DM, DM, WT + W_UP10, FF / 16, 0.f, G);
    { pg8::EpiSwiglu E{big, FF}; GEMM(pg8::EpiSwiglu, E, hb, WT + W_UP10, TOK, 2 * FF, DM); }
    xcd_barrier(bar);
    meta_phase<MK_RESID>(a, lds, big + (size_t)TOK * FF, FF, WT + W_DN10, DM / 16, 0.5f, G);
    { pg8::EpiResid E{a.in[0], a.out, Xm, Xm, 0.5f}; GEMM(pg8::EpiResid, E, big, WT + W_DN10, TOK, DM, FF); }
    xcd_barrier(bar);
    ln_phase<true, false>(a, lds, TOK + NMETA, lng + 0 * DM, lnb + 0 * DM, vcu, G);
    xcd_barrier(bar);
    meta_phase<MK_CONVIN>(a, lds, hb + (size_t)TOK * DM, DM, WT + W_CIN, 128, 0.f, G);
    { pg8::EpiConvIn E{big, big + (size_t)MT * DM}; GEMM(pg8::EpiConvIn, E, hb, WT + W_CIN, TOK, 3 * DM, DM); }
    xcd_barrier(bar);
    conv_phase(a, G);
    xcd_barrier(bar);
    meta_phase<MK_RESID>(a, lds, big + (size_t)MT * DM + (size_t)TOK * DM, DM, WT + W_COUT, DM / 16, 1.0f, G);
    { pg8::EpiResid E{a.out, a.out, Xm, Xm, 1.0f}; GEMM(pg8::EpiResid, E, big + (size_t)MT * DM, WT + W_COUT, TOK, DM, DM); }
    xcd_barrier(bar);
    ln_phase<true, false>(a, lds, TOK + NMETA, lng + 1 * DM, lnb + 1 * DM, vcu, G);
    xcd_barrier(bar);
    meta_phase<MK_SWIGLU>(a, lds, hb + (size_t)TOK * DM, DM, WT + W_UP20, FF / 16, 0.f, G);
    { pg8::EpiSwiglu E{big, FF}; GEMM(pg8::EpiSwiglu, E, hb, WT + W_UP20, TOK, 2 * FF, DM); }
    xcd_barrier(bar);
    meta_phase<MK_RESID>(a, lds, big + (size_t)TOK * FF, FF, WT + W_DN20, DM / 16, 0.5f, G);
    { pg8::EpiResid E{a.out, a.out, Xm, Xm, 0.5f}; GEMM(pg8::EpiResid, E, big, WT + W_DN20, TOK, DM, FF); }
    xcd_barrier(bar);
    ln_phase<true, true>(a, lds, TOK + NMETA, lng + 2 * DM, lnb + 2 * DM, vcu, G);
    xcd_barrier(bar);
    meta_phase<MK_KV>(a, lds, hb + (size_t)TOK * DM, DM, WT + W_KV, 2 * DM / 16, 0.f, G);
    { pg8::EpiKV E{WT  , (bf16*)(a.ws + WS_V)}; GEMM(pg8::EpiKV, E, hb, WT + W_KV, TOK, 2 * DM, DM); }
    { pg8::EpiSwiglu E{big, FF}; GEMM(pg8::EpiSwiglu, E, hb, WT + W_UP11, TOK, 2 * FF, DM); }
    for (int bh = G - 1 - bx; bh < 2 * NH; bh += G) scan_bh(a, lds, bh);
    xcd_barrier(bar);
    { pg8::EpiResid E{a.out, a.out, Xm, Xm, 0.5f}; GEMM(pg8::EpiResid, E, big, WT + W_DN11, TOK, DM, FF); }
    xcd_barrier(bar);
    ln_phase<true, false>(a, lds, TOK, lng + 3 * DM, lnb + 3 * DM, vcu, G);
    xcd_barrier(bar);
    { pg8::EpiQ E{big}; GEMM(pg8::EpiQ, E, hb, WT + W_Q, TOK, DM, DM); }
    xcd_barrier(bar);
    attn_phase(a, (char*)lds_raw, vcu, G);
    xcd_barrier(bar);
    { pg8::EpiResid E{a.out, a.out, Xm, Xm, 1.0f}; GEMM(pg8::EpiResid, E, big + (size_t)16 * MiB  , WT + W_O, TOK, DM, DM); }
    xcd_barrier(bar);
    ln_phase<true, false>(a, lds, TOK, lng + 4 * DM, lnb + 4 * DM, vcu, G);
    xcd_barrier(bar);
    { pg8::EpiSwiglu E{big, FF}; GEMM(pg8::EpiSwiglu, E, hb, WT + W_UP21, TOK, 2 * FF, DM); }
    xcd_barrier(bar);
    { pg8::EpiResid E{a.out, a.out, Xm, Xm, 0.5f}; GEMM(pg8::EpiResid, E, big, WT + W_DN21, TOK, DM, FF); }
    xcd_barrier(bar);
    ln_phase<false, false>(a, lds, TOK, lng + 5 * DM, lnb + 5 * DM, vcu, G);
#undef GEMM
}

extern "C" void kernel_launch(void* const* d_in, const int* in_sizes, int n_in, void* d_out, int out_size, void* d_ws, size_t ws_size, hipStream_t stream) {
    static int grid = 0;
    if (grid == 0) {
        if (n_in != 17 || in_sizes[0] != TOK * DM || out_size != TOK * DM || ws_size < WS_END) {
            fprintf(stderr, "kernel_launch: unexpected shapes (n_in %d, in0 %d, out %d, ws %zu); nothing launched\n", n_in, n_in > 0 ? in_sizes[0] : -1, out_size, ws_size); grid = -1; return; }
        int dev = 0, cus = 0, per_cu = 0;
        (void)hipGetDevice(&dev); (void)hipDeviceGetAttribute(&cus, hipDeviceAttributeMultiprocessorCount, dev);
        if (hipFuncSetAttribute((const void*)yoco_fwd, hipFuncAttributeMaxDynamicSharedMemorySize, LDS_TOTAL) != hipSuccess) { fprintf(stderr, "kernel_launch: hipFuncSetAttribute failed\n"); grid = -1; return; }
        if (hipOccupancyMaxActiveBlocksPerMultiprocessor(&per_cu, (const void*)yoco_fwd, NTHR, LDS_TOTAL) != hipSuccess || per_cu < 1) { fprintf(stderr, "kernel_launch: occupancy query says %d blocks/CU\n", per_cu); grid = -1; return; }
        grid = cus;
    }
    if (grid < 0) return;
    if (hipMemsetAsync(d_ws, 0, 65536, stream) != hipSuccess) { fprintf(stderr, "kernel_launch: memset failed\n"); return; }
    Args a{};
    for (int i = 0; i < 17; ++i) a.in[i] = (const float*)d_in[i];
    a.out = (float*)d_out; a.ws = (unsigned char*)d_ws;
    void* args[] = {&a};
    hipError_t e = hipLaunchCooperativeKernel((const void*)yoco_fwd, dim3(grid), dim3(NTHR), args, LDS_TOTAL, stream);
    if (e != hipSuccess) fprintf(stderr, "kernel_launch: cooperative launch failed: %s (grid %d)\n", hipGetErrorString(e), grid);
}
```
